# Optimizing an MI355X kernel written in HIP

```python
import math
import jax, jax.numpy as jnp
from jax import lax
import numpy as np

D_MODEL = 1024
BATCH = 4
SEQ = 4096
DEPTH = 4

MIX_WIDTH = D_MODEL
ATTN_HEAD_DIM = 64
ATTN_WIDTH = D_MODEL // 2
N_ATTN_HEADS = ATTN_WIDTH // ATTN_HEAD_DIM
DILATED_PATTERNS = ((128, 1), (512, 4), (2048, 16))
N_MLSTM_HEADS = 4
MLSTM_WIDTH = MIX_WIDTH - ATTN_WIDTH
MLSTM_HEAD_DIM = MLSTM_WIDTH // N_MLSTM_HEADS
MLSTM_CHUNK = 128
MLSTM_CONV = 4
IN_COLS = 3 * ATTN_WIDTH + 4 * MLSTM_WIDTH + 2 * N_MLSTM_HEADS
N_BUCKETS = 32
MAX_DISTANCE = 2048
N_MEM = 256
N_XHEADS = 4
XHEAD_DIM = D_MODEL // N_XHEADS
D_FF = 2816
FFN_CONV = 3
EPS = 1e-6

kernel_name = "hybrid_dilattn_mlstm_memxattn_convffn"


def rmsnorm(x, g):
    x32 = x.astype(jnp.float32)
    y = x32 * lax.rsqrt(jnp.mean(x32 * x32, axis=-1, keepdims=True) + EPS)
    return (y * g.astype(jnp.float32)).astype(x.dtype)


def causal_dwconv(x, w, b):
    K = w.shape[0]
    S = x.shape[1]
    xp = jnp.pad(x, ((0, 0), (K - 1, 0), (0, 0)))
    y = b + xp[:, 0:S] * w[0]
    for j in range(1, K):
        y = y + xp[:, j:j + S] * w[j]
    return y


def t5_causal_bucket(dist):
    max_exact = N_BUCKETS // 2
    d_f = jnp.maximum(dist, 1).astype(jnp.float32)
    large = max_exact + (jnp.log(d_f / max_exact) / math.log(MAX_DISTANCE / max_exact)
                         * (N_BUCKETS - max_exact)).astype(jnp.int32)
    large = jnp.minimum(large, N_BUCKETS - 1)
    return jnp.where(dist < max_exact, dist, large)


def dilated_window_attention(q, k, v, bias_sub, dil):
    B, H, S, Dh = q.shape
    n = bias_sub.shape[1] - 1
    blk = n
    span = dil * blk
    L = -(-S // span) * span
    M = L // dil
    nb = M // blk

    def to_blocks(t):
        t = jnp.pad(t, ((0, 0), (0, 0), (0, L - S), (0, 0)))
        t = t.reshape(B, H, M, dil, Dh).swapaxes(2, 3)
        return t.reshape(B, H, dil, nb, blk, Dh)

    def with_prev(t):
        prev = jnp.pad(t, ((0, 0), (0, 0), (0, 0), (1, 0), (0, 0), (0, 0)))[:, :, :, :nb]
        return jnp.concatenate([prev, t], axis=-2)

    qb = to_blocks(q)
    kw = with_prev(to_blocks(k))
    vw = with_prev(to_blocks(v))
    logits = jnp.einsum("bhcnqd,bhcnkd->bhcnqk", qb, kw) * (Dh ** -0.5)
    qi = jnp.arange(blk)[:, None]
    kj = jnp.arange(2 * blk)[None, :]
    dist = qi + blk - kj
    band = (dist >= 0) & (dist <= n)
    bias = bias_sub[:, jnp.clip(dist, 0, n)]
    has_prev = (jnp.arange(nb)[:, None, None] > 0) | (kj[None] >= blk)
    valid = band[None] & has_prev
    logits = jnp.where(valid, logits + bias[:, None, None], -jnp.inf)
    m = jnp.max(logits, axis=-1, keepdims=True)
    p = jnp.exp(logits - m)
    s = jnp.sum(p, axis=-1, keepdims=True)
    o = jnp.einsum("bhcnqk,bhcnkd->bhcnqd", p, vw) / s
    lse = (m + jnp.log(s))[..., 0]
    o = o.reshape(B, H, dil, M, Dh).swapaxes(2, 3).reshape(B, H, L, Dh)[:, :, :S]
    lse = lse.reshape(B, H, dil, M).swapaxes(2, 3).reshape(B, H, L)[:, :, :S]
    return o, lse


def mlstm_chunkwise(q, k, v, i_pre, f_pre):
    B, H, S, Dh = q.shape
    nc = S // MLSTM_CHUNK

    def cs(t):
        return t.reshape((B, H, nc, MLSTM_CHUNK) + t.shape[3:])

    qc, kc, vc = cs(q), cs(k), cs(v)
    ig = cs(i_pre)
    b = jnp.cumsum(cs(jax.nn.log_sigmoid(f_pre)), axis=-1)
    g = b[..., -1]
    w = g[..., None] - b + ig

    def step(carry, inp):
        C, n, m = carry
        k_c, v_c, w_c, g_c = inp
        m_new = jnp.maximum(g_c + m, jnp.max(w_c, axis=-1))
        decay = jnp.exp(g_c + m - m_new)
        wt = jnp.exp(w_c - m_new[..., None])
        C_new = decay[..., None, None] * C + jnp.einsum("bhs,bhsv,bhsk->bhvk", wt, v_c, k_c)
        n_new = decay[..., None] * n + jnp.einsum("bhs,bhsk->bhk", wt, k_c)
        return (C_new, n_new, m_new), (C, n, m)

    init = (jnp.zeros((B, H, Dh, Dh), jnp.float32),
            jnp.zeros((B, H, Dh), jnp.float32),
            jnp.zeros((B, H), jnp.float32))
    lead = lambda t: jnp.moveaxis(t, 2, 0)
    _, (C_prev, n_prev, m_prev) = lax.scan(step, init, (lead(kc), lead(vc), lead(w), lead(g)))
    C_prev = jnp.moveaxis(C_prev, 0, 2)
    n_prev = jnp.moveaxis(n_prev, 0, 2)
    m_prev = jnp.moveaxis(m_prev, 0, 2)

    t_idx = jnp.arange(MLSTM_CHUNK)
    causal = t_idx[:, None] >= t_idx[None, :]
    D = jnp.where(causal, b[..., :, None] - b[..., None, :] + ig[..., None, :], -jnp.inf)
    a = b + m_prev[..., None]
    m_t = jnp.maximum(a, jnp.max(D, axis=-1))
    P = jnp.exp(D - m_t[..., None]) * jnp.einsum("bhntd,bhnsd->bhnts", qc, kc)
    inter = jnp.exp(a - m_t)
    num = (inter[..., None] * jnp.einsum("bhnvk,bhntk->bhntv", C_prev, qc)
           + jnp.einsum("bhnts,bhnsv->bhntv", P, vc))
    den = inter * jnp.einsum("bhnk,bhntk->bhnt", n_prev, qc) + jnp.sum(P, axis=-1)
    h = num / jnp.maximum(jnp.abs(den), jnp.exp(-m_t))[..., None]
    return h.reshape(B, H, S, Dh)


def hybrid_mixer(h, rel_bias, w_in, mconv_w, mconv_b, b_ig, b_fg, g_attn_out, g_mlstm_out, w_out):
    B, S, _ = h.shape
    f32 = jnp.float32
    proj = h @ w_in
    sizes = [ATTN_WIDTH] * 3 + [MLSTM_WIDTH] * 4 + [N_MLSTM_HEADS] * 2
    idx = [int(s) for s in np.cumsum(sizes)[:-1]]
    qa, ka, va, qm, km, vm, om, ig, fg = jnp.split(proj, idx, axis=-1)

    def heads(t, nh):
        return t.reshape(B, S, nh, -1).transpose(0, 2, 1, 3)

    qa_ = heads(qa, N_ATTN_HEADS).astype(f32)
    ka_ = heads(ka, N_ATTN_HEADS).astype(f32)
    va_ = heads(va, N_ATTN_HEADS).astype(f32)
    outs, lses = [], []
    for window, dil in DILATED_PATTERNS:
        n = window // dil
        bias_sub = rel_bias[t5_causal_bucket(jnp.arange(n + 1) * dil)].T.astype(f32)
        o, l = dilated_window_attention(qa_, ka_, va_, bias_sub, dil)
        outs.append(o)
        lses.append(l)
    mix_w = jax.nn.softmax(jnp.stack(lses), axis=0)
    attn = jnp.einsum("pbhs,pbhsd->bhsd", mix_w, jnp.stack(outs))
    attn = attn.transpose(0, 2, 1, 3).reshape(B, S, ATTN_WIDTH).astype(h.dtype)

    qk = jax.nn.silu(causal_dwconv(jnp.concatenate([qm, km], axis=-1), mconv_w, mconv_b))
    qm, km = jnp.split(qk, 2, axis=-1)
    q = heads(qm, N_MLSTM_HEADS).astype(f32)
    k = heads(km, N_MLSTM_HEADS).astype(f32) * (MLSTM_HEAD_DIM ** -0.5)
    v = heads(vm, N_MLSTM_HEADS).astype(f32)
    i_pre = (ig + b_ig).astype(f32).transpose(0, 2, 1)
    f_pre = (fg + b_fg).astype(f32).transpose(0, 2, 1)
    hm = mlstm_chunkwise(q, k, v, i_pre, f_pre)
    hm = jax.nn.sigmoid(om.astype(f32)) * hm.transpose(0, 2, 1, 3).reshape(B, S, MLSTM_WIDTH)

    mixed = jnp.concatenate([rmsnorm(attn, g_attn_out), rmsnorm(hm.astype(h.dtype), g_mlstm_out)], axis=-1)
    return mixed @ w_out


def memory_cross_attention(h, mem, wq, wk, wv, wo):
    B, S, D = h.shape
    f32 = jnp.float32
    q = (h @ wq).reshape(B, S, N_XHEADS, XHEAD_DIM).astype(f32)
    k = (mem @ wk).reshape(B, -1, N_XHEADS, XHEAD_DIM).astype(f32)
    v = (mem @ wv).reshape(B, -1, N_XHEADS, XHEAD_DIM).astype(f32)
    p = jax.nn.softmax(jnp.einsum("bshd,bmhd->bhsm", q, k) * (XHEAD_DIM ** -0.5), axis=-1)
    o = jnp.einsum("bhsm,bmhd->bshd", p, v).reshape(B, S, D).astype(h.dtype)
    return o @ wo


def conv_ffn(h, w_up, conv_w, conv_b, w_down):
    u = causal_dwconv(h @ w_up, conv_w, conv_b)
    a, g = jnp.split(u, 2, axis=-1)
    return (jax.nn.gelu(g, approximate=True) * a) @ w_down


def setup_inputs(seed: int = 0) -> dict:
    key = jax.random.key(seed)
    ks = jax.random.split(key, 32)
    f32 = jnp.float32

    def nrm(k, shape, scale):
        return scale * jax.random.normal(k, shape, f32)

    def gain(k, shape):
        return 1.0 + 0.02 * jax.random.normal(k, shape, f32)

    L, D = DEPTH, D_MODEL
    return {
        "x": nrm(ks[0], (BATCH, SEQ, D), 1.0),
        "mem": nrm(ks[1], (BATCH, N_MEM, D), 1.0),
        "rel_bias": nrm(ks[2], (N_BUCKETS, N_ATTN_HEADS), 0.2),
        "pre_mix_g": gain(ks[3], (L, D)),
        "w_in": nrm(ks[4], (L, D, IN_COLS), D ** -0.5),
        "mconv_w": nrm(ks[5], (L, MLSTM_CONV, 2 * MLSTM_WIDTH), MLSTM_CONV ** -0.5),
        "mconv_b": nrm(ks[6], (L, 2 * MLSTM_WIDTH), 0.02),
        "b_igate": nrm(ks[7], (L, N_MLSTM_HEADS), 0.1),
        "b_fgate": jnp.linspace(3.0, 6.0, N_MLSTM_HEADS, dtype=f32)[None] + nrm(ks[8], (L, N_MLSTM_HEADS), 0.1),
        "attn_out_g": gain(ks[9], (L, ATTN_WIDTH)),
        "mlstm_out_g": gain(ks[10], (L, MLSTM_WIDTH)),
        "w_out": nrm(ks[11], (L, MIX_WIDTH, D), MIX_WIDTH ** -0.5),
        "post_mix_g": gain(ks[12], (L, D)),
        "pre_mem_g": gain(ks[13], (L, D)),
        "wq_mem": nrm(ks[14], (L, D, D), D ** -0.5),
        "wk_mem": nrm(ks[15], (L, D, D), D ** -0.5),
        "wv_mem": nrm(ks[16], (L, D, D), D ** -0.5),
        "wo_mem": nrm(ks[17], (L, D, D), D ** -0.5),
        "post_mem_g": gain(ks[18], (L, D)),
        "pre_ffn_g": gain(ks[19], (L, D)),
        "w_up": nrm(ks[20], (L, D, 2 * D_FF), D ** -0.5),
        "fconv_w": nrm(ks[21], (L, FFN_CONV, 2 * D_FF), FFN_CONV ** -0.5),
        "fconv_b": nrm(ks[22], (L, 2 * D_FF), 0.02),
        "w_down": nrm(ks[23], (L, D_FF, D), D_FF ** -0.5),
        "post_ffn_g": gain(ks[24], (L, D)),
    }


def reference(x, mem, rel_bias, pre_mix_g, w_in, mconv_w, mconv_b, b_igate, b_fgate,
              attn_out_g, mlstm_out_g, w_out, post_mix_g, pre_mem_g, wq_mem, wk_mem,
              wv_mem, wo_mem, post_mem_g, pre_ffn_g, w_up, fconv_w, fconv_b, w_down,
              post_ffn_g):
    for l in range(DEPTH):
        h = hybrid_mixer(rmsnorm(x, pre_mix_g[l]), rel_bias, w_in[l], mconv_w[l], mconv_b[l],
                         b_igate[l], b_fgate[l], attn_out_g[l], mlstm_out_g[l], w_out[l])
        x = x + rmsnorm(h, post_mix_g[l])
        h = memory_cross_attention(rmsnorm(x, pre_mem_g[l]), mem, wq_mem[l], wk_mem[l],
                                   wv_mem[l], wo_mem[l])
        x = x + rmsnorm(h, post_mem_g[l])
        h = conv_ffn(rmsnorm(x, pre_ffn_g[l]), w_up[l], fconv_w[l], fconv_b[l], w_down[l])
        x = x + rmsnorm(h, post_ffn_g[l])
    return x
```

```cpp
#include <hip/hip_runtime.h>
#include <hip/hip_cooperative_groups.h>
#include <cstdio>
#include <cstdint>
namespace cg = cooperative_groups;

#ifndef MK_PER_PHASE_LAUNCH
#define MK_PER_PHASE_LAUNCH 1
#endif

namespace pg8 {
#define PG8_LAS __attribute__((address_space(3)))
typedef unsigned short bf16_t;
typedef short bf16x8 __attribute__((ext_vector_type(8)));
typedef float f32x4 __attribute__((ext_vector_type(4)));
typedef unsigned u32x4 __attribute__((ext_vector_type(4)));
constexpr int BM = 256, BK = 64, HALF = 128, HTB = HALF * BK * 2, STAGE_BYTES = 8 * HTB, NXCD = 8, WGM = 8;

__host__ __device__ __forceinline__ int lds_byte(int r, int c) { const int st = (r >> 4) * 2 + (c >> 5), rr = r & 15, cc = c & 31, ob = rr * 64 + cc * 2; return st * 1024 + (ob ^ (((ob >> 9) & 1) << 5)); }
__host__ __device__ __forceinline__ void stage_rc(int b, int& R, int& C) { const int st = b / 1024, sb = b % 1024, swz = sb ^ (((sb >> 9) & 1) << 5); R = (st >> 1) * 16 + swz / 64; C = (st & 1) * 32 + (swz % 64) / 2; }
__host__ __device__ __forceinline__ int perm32(int rho) { const int n = rho >> 4, i = rho & 15; return 8 * (i >> 2) + 4 * n + (i & 3); }

struct Unit { int pm, pn; };
struct Gemm { const bf16_t* A; const bf16_t* Bt; int M, N, K; };

struct StaticOrder {
    int nM, nN, nwg, G, c;
    __host__ __device__ void init(int M, int N, int G_, int c_) { nM = M / BM; nN = N / BM; nwg = nM * nN; G = G_; c = c_; }
    __host__ __device__ bool next(int i, Unit& u) const {
        const long L = (long)i * G + c; if (L >= nwg) return false;
        int wgid = (int)L; { const int q = nwg / NXCD, r = nwg % NXCD, xcd = wgid % NXCD, off = wgid / NXCD; wgid = (xcd < r ? xcd * (q + 1) : r * (q + 1) + (xcd - r) * q) + off; }
        const int nig = WGM * nN, gid = wgid / nig, fm = gid * WGM, gsz = (nM - fm) < WGM ? (nM - fm) : WGM;
        u.pm = fm + ((wgid % nig) % gsz); u.pn = (wgid % nig) / gsz; return true;
    }
    __device__ __forceinline__ void a_ready(const Unit&) const {}
    __device__ __forceinline__ void done(const Unit&) const {}
};

__device__ __forceinline__ unsigned cvt_pk_bf16(float lo, float hi) { unsigned r; asm volatile("v_cvt_pk_bf16_f32 %0, %1, %2" : "=v"(r) : "v"(lo), "v"(hi)); return r; }

struct EpiBf16 {
    static constexpr bool PERM = true, AFTER_DRAIN = false;
    bf16_t* O; int ldc;
    __device__ __forceinline__ void operator()(const f32x4 (&acc)[2][2][4][2], const Unit& u, int wr, int wc, int fr, int fq) const {
        const int row0 = u.pm * BM + wr * 64 + fr; const int col0 = u.pn * BM + wc * 32 + 8 * fq;
#pragma unroll
        for (int ai = 0; ai < 2; ++ai)
#pragma unroll
            for (int m = 0; m < 4; ++m) { bf16_t* rowp = O + (size_t)(row0 + ai * HALF + m * 16) * ldc + col0;
#pragma unroll
                for (int bj = 0; bj < 2; ++bj) { const f32x4 v0 = acc[ai][bj][m][0], v1 = acc[ai][bj][m][1];
                    u32x4 w; w.x = cvt_pk_bf16(v0[0], v0[1]); w.y = cvt_pk_bf16(v0[2], v0[3]); w.z = cvt_pk_bf16(v1[0], v1[1]); w.w = cvt_pk_bf16(v1[2], v1[3]);
                    *(u32x4*)(rowp + bj * HALF) = w; } }
    }
};

template <class Epi, class Sched, bool ALIGN_EPI = false, bool SP2 = false>
__device__ __forceinline__ void gemm_phase(PG8_LAS unsigned char* lds, const Gemm g, const Sched& S, const Epi& E) {
    int tid_ = threadIdx.x; asm volatile("" : "+v"(tid_)); const int tid = tid_, wid = __builtin_amdgcn_readfirstlane(tid >> 6), lane = tid & 63, wr = wid >> 2, wc = wid & 3, fr = lane & 15, fq = lane >> 4;
    const int K = g.K, nt = K / BK;
    unsigned voffA[2], voffB[2];
#pragma unroll
    for (int i = 0; i < 2; ++i) { int R, C; stage_rc(tid * 16 + i * 8192, R, C); const int Rb = Epi::PERM ? ((R & ~31) + perm32(R & 31)) : R;
        voffA[i] = (unsigned)(R * K + C) * 2u; voffB[i] = (unsigned)(Rb * K + C) * 2u; }
    const size_t kstep = (size_t)(BK * 2);
    const size_t hstep = (size_t)HALF * K * 2;
    const size_t tstep = 2 * hstep;
    const unsigned ldsw = (unsigned)wid * 1024u;
    const int aoff = lds_byte(wr * 64 + fr, fq * 8), boff = lds_byte(wc * 32 + fr, fq * 8);
#define PG8_SA(b, h) (((b) * 2 + (h)) * HTB)
#define PG8_SB(b, h) ((4 + (b) * 2 + (h)) * HTB)
#define PG8_STAGE(bufoff, gbase, voff) do { _Pragma("unroll") for (int _i = 0; _i < 2; ++_i) \
        __builtin_amdgcn_global_load_lds((const unsigned*)((const char*)(gbase) + (voff)[_i]), (PG8_LAS unsigned*)(lds + (bufoff) + ldsw + _i * 8192), 16, 0, 0); } while (0)
#define PG8_LDA(dst, b, h) do { _Pragma("unroll") for (int m = 0; m < 4; ++m) _Pragma("unroll") for (int k = 0; k < 2; ++k) dst[m][k] = *(const PG8_LAS bf16x8*)(lds + PG8_SA(b, h) + aoff + m * 2048 + k * 1024); } while (0)
#define PG8_LDB(dst, b, h) do { _Pragma("unroll") for (int n = 0; n < 2; ++n) _Pragma("unroll") for (int k = 0; k < 2; ++k) dst[n][k] = *(const PG8_LAS bf16x8*)(lds + PG8_SB(b, h) + boff + n * 2048 + k * 1024); } while (0)
#define PG8_MMA(ai, bj, At, Bt) do { __builtin_amdgcn_s_setprio(1); _Pragma("unroll") for (int m = 0; m < 4; ++m) _Pragma("unroll") for (int n = 0; n < 2; ++n) _Pragma("unroll") for (int k = 0; k < 2; ++k) \
        acc[ai][bj][m][n] = __builtin_amdgcn_mfma_f32_16x16x32_bf16(Bt[n][k], At[m][k], acc[ai][bj][m][n], 0, 0, 0); __builtin_amdgcn_s_setprio(0); } while (0)
#define PG8_WAIT_V(n) asm volatile("s_waitcnt vmcnt(" #n ")" ::: "memory")
#define PG8_WAIT_L(n) asm volatile("s_waitcnt lgkmcnt(" #n ")" ::: "memory")
#define PG8_BAR __builtin_amdgcn_s_barrier()
#define PG8_SCHED __builtin_amdgcn_sched_barrier(0)
    Unit cur, nxt; int ui = 0;
    if (!S.next(0, cur)) return;
    f32x4 acc[2][2][4][2];
#pragma unroll
    for (int a = 0; a < 2; ++a)
#pragma unroll
        for (int b = 0; b < 2; ++b)
#pragma unroll
            for (int m = 0; m < 4; ++m)
#pragma unroll
                for (int n = 0; n < 2; ++n) acc[a][b][m][n] = (f32x4){0.f, 0.f, 0.f, 0.f};
    bf16x8 At[4][2], B0[2][2], B1[2][2];
    const char* cA = (const char*)g.A + (size_t)cur.pm * tstep; const char* cB = (const char*)g.Bt + (size_t)cur.pn * tstep;
    S.a_ready(cur);
    if constexpr (SP2) {
        PG8_STAGE(PG8_SB(0, 0), cB, voffB); PG8_STAGE(PG8_SB(0, 1), cB + hstep, voffB); PG8_STAGE(PG8_SA(0, 0), cA, voffA); PG8_STAGE(PG8_SA(0, 1), cA + hstep, voffA);
        if (wr == 1) PG8_BAR;
        PG8_WAIT_V(2); PG8_BAR;
        PG8_STAGE(PG8_SB(1, 0), cB + kstep, voffB); PG8_STAGE(PG8_SA(1, 0), cA + kstep, voffA); PG8_STAGE(PG8_SB(1, 1), cB + hstep + kstep, voffB);
        PG8_WAIT_V(6); PG8_BAR;
    } else {
        PG8_STAGE(PG8_SB(0, 0), cB, voffB); PG8_STAGE(PG8_SA(0, 0), cA, voffA); PG8_STAGE(PG8_SB(0, 1), cB + hstep, voffB); PG8_STAGE(PG8_SA(0, 1), cA + hstep, voffA);
        if (wr == 1) PG8_BAR;
        PG8_WAIT_V(4); PG8_BAR;
        PG8_STAGE(PG8_SB(1, 0), cB + kstep, voffB); PG8_STAGE(PG8_SA(1, 0), cA + kstep, voffA); PG8_STAGE(PG8_SB(1, 1), cB + hstep + kstep, voffB);
        PG8_WAIT_V(6); PG8_BAR;
    }
    for (;;) {
        const bool has_next = S.next(ui + 1, nxt);
        const char* nA = has_next ? (const char*)g.A + (size_t)nxt.pm * tstep : cA; const char* nB = has_next ? (const char*)g.Bt + (size_t)nxt.pn * tstep : cB;
        for (int t = 0; t < nt; t += 2) {
            const bool last = (t == nt - 2);
            const char* a1 = cA + (size_t)(t + 1) * kstep;
            const char* a2 = last ? nA : cA + (size_t)(t + 2) * kstep; const char* b2 = last ? nB : cB + (size_t)(t + 2) * kstep;
            const char* a3 = a2 + kstep; const char* b3 = b2 + kstep;
            if (last && has_next) S.a_ready(nxt);
            if constexpr (SP2) {
            PG8_LDB(B0, 0, 0); PG8_LDB(B1, 0, 1); PG8_SCHED; PG8_LDA(At, 0, 0); PG8_STAGE(PG8_SA(1, 1), a1 + hstep, voffA);
            PG8_WAIT_V(8); PG8_WAIT_L(0); PG8_BAR; PG8_MMA(0, 0, At, B0); PG8_MMA(0, 1, At, B1); PG8_BAR; PG8_SCHED;
            PG8_LDA(At, 0, 1); PG8_STAGE(PG8_SB(0, 0), b2, voffB); PG8_STAGE(PG8_SB(0, 1), b2 + hstep, voffB); PG8_STAGE(PG8_SA(0, 0), a2, voffA);
            PG8_WAIT_V(8); PG8_WAIT_L(0); PG8_BAR; PG8_MMA(1, 0, At, B0); PG8_MMA(1, 1, At, B1); PG8_BAR; PG8_SCHED;
            PG8_LDB(B0, 1, 0); PG8_LDB(B1, 1, 1); PG8_SCHED; PG8_LDA(At, 1, 0); PG8_STAGE(PG8_SA(0, 1), a2 + hstep, voffA);
            PG8_WAIT_V(8); PG8_WAIT_L(0); PG8_BAR; PG8_MMA(0, 0, At, B0); PG8_MMA(0, 1, At, B1); PG8_BAR; PG8_SCHED;
            PG8_LDA(At, 1, 1); PG8_STAGE(PG8_SB(1, 0), b3, voffB); PG8_STAGE(PG8_SB(1, 1), b3 + hstep, voffB); PG8_STAGE(PG8_SA(1, 0), a3, voffA);
            PG8_WAIT_V(8); PG8_WAIT_L(0); PG8_BAR; PG8_MMA(1, 0, At, B0); PG8_MMA(1, 1, At, B1); PG8_BAR; PG8_SCHED;
            } else {
            PG8_LDB(B0, 0, 0); PG8_SCHED; PG8_LDA(At, 0, 0); PG8_STAGE(PG8_SA(1, 1), a1 + hstep, voffA);
            PG8_WAIT_L(8); PG8_BAR; PG8_WAIT_L(0); PG8_MMA(0, 0, At, B0); PG8_BAR; PG8_SCHED;
            PG8_LDB(B1, 0, 1); PG8_STAGE(PG8_SB(0, 0), b2, voffB);
            PG8_BAR; PG8_WAIT_L(0); PG8_MMA(0, 1, At, B1); PG8_BAR;
            PG8_LDA(At, 0, 1); PG8_STAGE(PG8_SA(0, 0), a2, voffA);
            PG8_BAR; PG8_WAIT_L(0); PG8_MMA(1, 0, At, B0); PG8_BAR; PG8_SCHED;
            PG8_STAGE(PG8_SB(0, 1), b2 + hstep, voffB);
            PG8_WAIT_V(6); PG8_BAR; PG8_MMA(1, 1, At, B1); PG8_BAR;
            PG8_LDB(B0, 1, 0); PG8_SCHED; PG8_LDA(At, 1, 0); PG8_STAGE(PG8_SA(0, 1), a2 + hstep, voffA);
            PG8_WAIT_L(8); PG8_BAR; PG8_WAIT_L(0); PG8_MMA(0, 0, At, B0); PG8_BAR; PG8_SCHED;
            PG8_LDB(B1, 1, 1); PG8_STAGE(PG8_SB(1, 0), b3, voffB);
            PG8_BAR; PG8_WAIT_L(0); PG8_MMA(0, 1, At, B1); PG8_BAR;
            PG8_LDA(At, 1, 1); PG8_STAGE(PG8_SA(1, 0), a3, voffA);
            PG8_BAR; PG8_WAIT_L(0); PG8_MMA(1, 0, At, B0); PG8_BAR; PG8_SCHED;
            PG8_STAGE(PG8_SB(1, 1), b3 + hstep, voffB);
            PG8_WAIT_V(6); PG8_BAR; PG8_MMA(1, 1, At, B1); PG8_BAR;
            }
        }
        if constexpr (ALIGN_EPI) { if (wr == 0) PG8_BAR; }
        if constexpr (!Epi::AFTER_DRAIN) { E(acc, cur, wr, wc, fr, fq); S.done(cur); }
        if (!has_next) break;
#pragma unroll
        for (int a = 0; a < 2; ++a)
#pragma unroll
            for (int b = 0; b < 2; ++b)
#pragma unroll
                for (int m = 0; m < 4; ++m)
#pragma unroll
                    for (int n = 0; n < 2; ++n) acc[a][b][m][n] = (f32x4){0.f, 0.f, 0.f, 0.f};
        cur = nxt; cA = nA; cB = nB; ++ui;
        if constexpr (ALIGN_EPI) { if (wr == 1) PG8_BAR; }
    }
    PG8_WAIT_V(0);
    if constexpr (!ALIGN_EPI) { if (wr == 0) PG8_BAR; }
    PG8_BAR;
#undef PG8_SA
#undef PG8_SB
#undef PG8_STAGE
#undef PG8_LDA
#undef PG8_LDB
#undef PG8_MMA
#undef PG8_WAIT_V
#undef PG8_WAIT_L
#undef PG8_BAR
#undef PG8_SCHED
}
}

constexpr int NWAVES = 8, NTHR = 512;
constexpr int DEPTH = 4, BATCH = 4, SEQ = 4096, DM = 1024, NTOK = BATCH * SEQ;
constexpr int INC = 3592, NPROJ = 3840;
constexpr int C_QA = 0, C_KA = 512, C_VA = 1024, C_QM = 1536, C_KM = 2048, C_VM = 2560, C_OM = 3072, C_IG = 3584, C_FG = 3588;
constexpr int DFF = 2816, DFF2 = 5632;
constexpr int NMEM = 256, NMEMROWS = BATCH * NMEM;
constexpr float EPS = 1e-6f;

constexpr size_t MiB = 1u << 20;
constexpr size_t WS_CTL = 0, CTL_ZERO_BYTES = 64 * 1024;
constexpr size_t WS_SMALL = 256 * 1024;
constexpr size_t WS_WIN = 1 * MiB, WS_WOUT = WS_WIN + (size_t)NPROJ * DM * 2, WS_WQ = WS_WOUT + 2 * MiB, WS_WO = WS_WQ + 2 * MiB,
                 WS_WUP = WS_WO + 2 * MiB, WS_WDN = WS_WUP + (size_t)DFF2 * DM * 2, WS_WEND = WS_WDN + (size_t)DM * DFF * 2;
constexpr size_t WS_KM = 31 * MiB;
constexpr size_t WS_VT = 39 * MiB;
constexpr size_t WS_XN = 47 * MiB;
constexpr size_t WS_GR = 79 * MiB;
constexpr size_t WS_Q = WS_GR, WS_O = WS_GR + 32 * MiB, WS_MIXED = WS_GR + 56 * MiB;
constexpr size_t WS_HM = WS_GR, WS_DC = WS_GR + 16 * MiB, WS_CP = WS_GR + 48 * MiB;
constexpr size_t WS_UR = 167 * MiB;
constexpr size_t WS_PROJ = WS_UR;
constexpr size_t WS_OP = WS_UR + 120 * MiB;
constexpr size_t WS_LSE = WS_UR + 168 * MiB;
constexpr size_t WS_H = WS_UR;
constexpr size_t WS_WKT = WS_UR, WS_WVT = WS_UR + 8 * MiB, WS_MEMB = WS_UR + 16 * MiB;
constexpr size_t WS_END = 343 * MiB;
static_assert(WS_WEND == 31 * MiB, "weight map");
constexpr int SM_DN = 0, SM_NP = 65536, SM_MLOC = 131072, SM_GS = 131072 + 512, SM_MP = 131072 + 1024;

constexpr int CW_BAR = 4096;

constexpr int RING_BYTES = 131072;
constexpr int LDS_MAIN = 143360;
constexpr int MISC_OFF = LDS_MAIN;
constexpr int LDS_BYTES = 147456;

#define GAS __attribute__((address_space(1)))
#define LAS __attribute__((address_space(3)))
typedef unsigned short bf16;
typedef unsigned u32x4 __attribute__((ext_vector_type(4)));
typedef unsigned u32x2 __attribute__((ext_vector_type(2)));
typedef float f32x4 __attribute__((ext_vector_type(4)));
typedef float f32x2 __attribute__((ext_vector_type(2)));
typedef short bf16x8 __attribute__((ext_vector_type(8)));
typedef __bf16 bf16x2_t __attribute__((ext_vector_type(2)));
typedef LAS unsigned char* ldsp;

__device__ __forceinline__ float bf2f(unsigned short h) { return __uint_as_float((unsigned)h << 16); }
__device__ __forceinline__ float bflo(unsigned w) { return __uint_as_float(w << 16); }
__device__ __forceinline__ float bfhi(unsigned w) { return __uint_as_float(w & 0xffff0000u); }
__device__ __forceinline__ unsigned pk2(float lo, float hi) { f32x2 v = {lo, hi}; bf16x2_t b = __builtin_convertvector(v, bf16x2_t); return __builtin_bit_cast(unsigned, b); }
__device__ __forceinline__ void unpack8(const u32x4 w, float* f) { f[0] = bflo(w.x); f[1] = bfhi(w.x); f[2] = bflo(w.y); f[3] = bfhi(w.y); f[4] = bflo(w.z); f[5] = bfhi(w.z); f[6] = bflo(w.w); f[7] = bfhi(w.w); }
__device__ __forceinline__ u32x4 pack8(const float* f) { u32x4 w; w.x = pk2(f[0], f[1]); w.y = pk2(f[2], f[3]); w.z = pk2(f[4], f[5]); w.w = pk2(f[6], f[7]); return w; }
__device__ __forceinline__ float wave_sum(float v) {
#pragma unroll
    for (int o = 1; o < 64; o <<= 1) v += __shfl_xor(v, o);
    return v;
}
#define MFMA16(a, b, c) __builtin_amdgcn_mfma_f32_16x16x32_bf16((a), (b), (c), 0, 0, 0)
#define LDS_WAIT() asm volatile("s_waitcnt lgkmcnt(0)" ::: "memory")

#define XB_TMO      128
#define XB_XCNT(j)  (256  + 64 * (j))
#define XB_XSUB(j)  (1280 + 64 * (j))
#define XB_XGEN(j)  (2304 + 64 * (j))
#define XB_TOP      3328
#define XB_TOPGEN   3392
#define XCD_BAR_WORDS 3456
#define XB_SPIN_CAP (1u << 20)
__device__ __forceinline__ unsigned xb_ld(unsigned* p)              { return __hip_atomic_load(p, __ATOMIC_RELAXED, __HIP_MEMORY_SCOPE_AGENT); }
__device__ __forceinline__ unsigned xb_add(unsigned* p, unsigned v) { return __hip_atomic_fetch_add(p, v, __ATOMIC_RELAXED, __HIP_MEMORY_SCOPE_AGENT); }
__device__ __forceinline__ unsigned xb_xcc_id() { return (unsigned)__builtin_amdgcn_s_getreg((3 << 11) | 20) & 0xFu; }
#define XB_SPIN(cond, bar) do { unsigned _sp = 0; while (cond) { __builtin_amdgcn_s_sleep(1); \
    if ((++_sp & 255u) == 0u) { if (xb_ld(&(bar)[XB_TMO])) break; if (_sp > XB_SPIN_CAP) { atomicAdd(&(bar)[XB_TMO], 1u); break; } } } } while (0)
struct XcdBarrier { unsigned* bar; unsigned x; volatile LAS unsigned* st; };
__device__ __forceinline__ XcdBarrier xcd_barrier_post(unsigned* bar, volatile LAS unsigned* st) {
    XcdBarrier b; b.bar = bar; b.x = xb_xcc_id(); b.st = st;
    if (threadIdx.x == 0) (void)xb_add(&bar[XB_XCNT(b.x)], 1u);
    return b;
}
__device__ __forceinline__ void xcd_barrier_complete(unsigned* bar, unsigned x, unsigned& nloc, unsigned& nx) {
    const unsigned G = gridDim.x * gridDim.y * gridDim.z;
    unsigned sum, cnt, mine, sp = 0u;
    for (;;) {
        sum = 0u; cnt = 0u; mine = 0u;
#pragma unroll
        for (unsigned j = 0; j < 16; ++j) { const unsigned c = xb_ld(&bar[XB_XCNT(j)]); sum += c; cnt += (c > 0u) ? 1u : 0u; mine = (j == x) ? c : mine; }
        if (sum == G) break;
        __builtin_amdgcn_s_sleep(1);
        if ((++sp & 255u) == 0u) { if (xb_ld(&bar[XB_TMO])) break; if (sp > XB_SPIN_CAP) { atomicAdd(&bar[XB_TMO], 1u); break; } }
    }
    nloc = mine > 0u ? mine : 1u; nx = cnt > 0u ? cnt : 1u;
}
__device__ __forceinline__ void xcd_barrier(const XcdBarrier& b) {
    asm volatile("s_waitcnt vmcnt(0)" ::: "memory");
    __syncthreads();
    if (threadIdx.x == 0) {
        unsigned* bar = b.bar;
        __builtin_amdgcn_s_waitcnt(0);
        unsigned nloc = b.st[0], nx = b.st[1];
        if (nloc == 0u) { xcd_barrier_complete(bar, b.x, nloc, nx); b.st[0] = nloc; b.st[1] = nx; }
        const unsigned old = xb_add(&bar[XB_XSUB(b.x)], 1u);
        const unsigned gen = old / nloc;
        if (old + 1u == (gen + 1u) * nloc) {
            __builtin_amdgcn_fence(__ATOMIC_RELEASE, "agent");
            asm volatile("s_waitcnt vmcnt(0)" ::: "memory");
            const unsigned og = xb_add(&bar[XB_TOP], 1u);
            const unsigned tg = og / nx;
            if (og + 1u == (tg + 1u) * nx) xb_add(&bar[XB_TOPGEN], 1u);
            else XB_SPIN(xb_ld(&bar[XB_TOPGEN]) == tg, bar);
            __builtin_amdgcn_fence(__ATOMIC_ACQUIRE, "agent");
            xb_add(&bar[XB_XGEN(b.x)], 1u);
            asm volatile("s_waitcnt vmcnt(0)" ::: "memory");
        } else {
            XB_SPIN(xb_ld(&bar[XB_XGEN(b.x)]) == gen, bar);
            __builtin_amdgcn_fence(__ATOMIC_ACQUIRE, "agent");
            asm volatile("s_waitcnt vmcnt(0)" ::: "memory");
        }
    }
    __syncthreads();
}

struct Args {
    const float* x; const float* mem; const float* rel_bias; const float* pre_mix_g; const float* w_in; const float* mconv_w; const float* mconv_b;
    const float* b_ig; const float* b_fg; const float* attn_out_g; const float* mlstm_out_g; const float* w_out; const float* post_mix_g; const float* pre_mem_g;
    const float* wq; const float* wk; const float* wv; const float* wo; const float* post_mem_g; const float* pre_ffn_g; const float* w_up; const float* fconv_w;
    const float* fconv_b; const float* w_down; const float* post_ffn_g;
    float* out; unsigned char* ws; int ph_lo, ph_hi;
};

__device__ __forceinline__ void transpose_item(const float* W, int K, int N, int Npad, bf16* WT, LAS float* scr, int item, int lane) {
    const int nblk = Npad / 32, kb = item / nblk, nb = item % nblk, k0 = 64 * kb, n0 = 32 * nb;
    const int nn = n0 + (lane & 31); const bool ok = nn < N;
#pragma unroll 8
    for (int i = 0; i < 32; ++i) { const int kk = 2 * i + (lane >> 5); scr[kk * 33 + (lane & 31)] = ok ? W[(size_t)(k0 + kk) * N + nn] : 0.f; }
    LDS_WAIT(); asm volatile("" ::: "memory");
    const int c = lane & 7;
#pragma unroll
    for (int j = 0; j < 4; ++j) { const int n = (lane >> 3) + 8 * j; const LAS float* s = scr + (8 * c) * 33 + n;
        u32x4 o; o.x = pk2(s[0 * 33], s[1 * 33]); o.y = pk2(s[2 * 33], s[3 * 33]); o.z = pk2(s[4 * 33], s[5 * 33]); o.w = pk2(s[6 * 33], s[7 * 33]);
        *(u32x4*)(WT + (size_t)(n0 + n) * K + k0 + 8 * c) = o; }
    LDS_WAIT(); asm volatile("" ::: "memory");
}

__device__ __forceinline__ void convert_layer_weights(const Args& a, int l, ldsp lds, int gw, int NGW, int wave, int lane) {
    LAS float* scr = (LAS float*)(lds + wave * 16384);
    unsigned char* ws = a.ws;
    constexpr int I_IN = (DM / 64) * (NPROJ / 32), I_SQ = (DM / 64) * (DM / 32), I_UP = (DM / 64) * (DFF2 / 32), I_DN = (DFF / 64) * (DM / 32);
    constexpr int NITEMS = I_IN + 3 * I_SQ + I_UP + I_DN;
    for (int it = gw; it < NITEMS; it += NGW) {
        int r = it;
        if (r < I_IN) { transpose_item(a.w_in + (size_t)l * DM * INC, DM, INC, NPROJ, (bf16*)(ws + WS_WIN), scr, r, lane); continue; } r -= I_IN;
        if (r < I_SQ) { transpose_item(a.w_out + (size_t)l * DM * DM, DM, DM, DM, (bf16*)(ws + WS_WOUT), scr, r, lane); continue; } r -= I_SQ;
        if (r < I_SQ) { transpose_item(a.wq + (size_t)l * DM * DM, DM, DM, DM, (bf16*)(ws + WS_WQ), scr, r, lane); continue; } r -= I_SQ;
        if (r < I_SQ) { transpose_item(a.wo + (size_t)l * DM * DM, DM, DM, DM, (bf16*)(ws + WS_WO), scr, r, lane); continue; } r -= I_SQ;
        if (r < I_UP) { transpose_item(a.w_up + (size_t)l * DM * DFF2, DM, DFF2, DFF2, (bf16*)(ws + WS_WUP), scr, r, lane); continue; } r -= I_UP;
        transpose_item(a.w_down + (size_t)l * DFF * DM, DFF, DM, DM, (bf16*)(ws + WS_WDN), scr, r, lane);
    }
}

__device__ __forceinline__ void row_pass(const bf16* H, const float* xin, float* xout, const float* gpost, const float* gpre, bf16* XN, int gw, int NGW, int lane) {
    for (int m = gw; m < NTOK; m += NGW) {
        float xv[2][8];
#pragma unroll
        for (int j = 0; j < 2; ++j) { const float* p = xin + (size_t)m * DM + j * 512 + lane * 8; const f32x4 a0 = *(const f32x4*)p, a1 = *(const f32x4*)(p + 4);
            xv[j][0] = a0[0]; xv[j][1] = a0[1]; xv[j][2] = a0[2]; xv[j][3] = a0[3]; xv[j][4] = a1[0]; xv[j][5] = a1[1]; xv[j][6] = a1[2]; xv[j][7] = a1[3]; }
        if (H) {
            float hv[2][8]; float hs = 0.f;
#pragma unroll
            for (int j = 0; j < 2; ++j) { const u32x4 w = *(const u32x4*)(H + (size_t)m * DM + j * 512 + lane * 8); unpack8(w, hv[j]);
#pragma unroll
                for (int i = 0; i < 8; ++i) hs += hv[j][i] * hv[j][i]; }
            const float rs = rsqrtf(wave_sum(hs) * (1.f / DM) + EPS);
#pragma unroll
            for (int j = 0; j < 2; ++j) { const float* gp = gpost + j * 512 + lane * 8; const f32x4 g0 = *(const f32x4*)gp, g1 = *(const f32x4*)(gp + 4);
#pragma unroll
                for (int i = 0; i < 4; ++i) { xv[j][i] += hv[j][i] * rs * g0[i]; xv[j][4 + i] += hv[j][4 + i] * rs * g1[i]; }
                float* o = xout + (size_t)m * DM + j * 512 + lane * 8;
                *(f32x4*)o = (f32x4){xv[j][0], xv[j][1], xv[j][2], xv[j][3]}; *(f32x4*)(o + 4) = (f32x4){xv[j][4], xv[j][5], xv[j][6], xv[j][7]}; }
        }
        if (XN) {
            float xs = 0.f;
#pragma unroll
            for (int j = 0; j < 2; ++j)
#pragma unroll
                for (int i = 0; i < 8; ++i) xs += xv[j][i] * xv[j][i];
            const float rx = rsqrtf(wave_sum(xs) * (1.f / DM) + EPS);
#pragma unroll
            for (int j = 0; j < 2; ++j) { const float* gp = gpre + j * 512 + lane * 8; const f32x4 g0 = *(const f32x4*)gp, g1 = *(const f32x4*)(gp + 4); float o[8];
#pragma unroll
                for (int i = 0; i < 4; ++i) { o[i] = xv[j][i] * rx * g0[i]; o[4 + i] = xv[j][4 + i] * rx * g1[i]; }
                *(u32x4*)(XN + (size_t)m * DM + j * 512 + lane * 8) = pack8(o); }
        }
    }
}

__device__ __forceinline__ float log_sigmoid(float x) { return fminf(x, 0.f) - log1pf(__expf(-fabsf(x))); }
__device__ __forceinline__ float sigmoidf_(float x) { return 1.f / (1.f + __expf(-x)); }
__device__ __forceinline__ int t5_bucket(int d) {
    if (d < 16) return d;
    int k = 0;
    k += d >= 22; k += d >= 30; k += d >= 40; k += d >= 54; k += d >= 73; k += d >= 99; k += d >= 134; k += d >= 182;
    k += d >= 246; k += d >= 332; k += d >= 450; k += d >= 609; k += d >= 825; k += d >= 1117; k += d >= 1513;
    return 16 + k;
}

constexpr int DA_KP = 144, DA_VP = 528;
constexpr int DA_K = 0, DA_V = 256 * DA_KP, DA_BIAS = DA_V + 64 * DA_VP;
__device__ __forceinline__ void da_unit(const Args& a, ldsp lds, int u) {
    int tid_ = threadIdx.x; asm volatile("" : "+v"(tid_)); const int tid = tid_, lane = tid & 63, wave = __builtin_amdgcn_readfirstlane(tid >> 6), fr = lane & 15, fq = lane >> 4;
    const int bh = u / 96, j = u % 96, b = bh >> 3, h = bh & 7, p = j >> 5, jj = j & 31;
    const int dil = 1 << (2 * p), nbp = 32 >> (2 * p), c = jj / nbp, nb = jj % nbp;
    const bf16* PROJ = (const bf16*)(a.ws + WS_PROJ);
    bf16* OP = (bf16*)(a.ws + WS_OP); float* LSE = (float*)(a.ws + WS_LSE);
    const size_t rowbase = (size_t)b * SEQ;
    LAS float* biasl = (LAS float*)(lds + DA_BIAS);
    if (tid < 129) biasl[tid] = a.rel_bias[t5_bucket(tid * dil) * 8 + h];
    for (int it = tid; it < 2048; it += NTHR) {
        const int kk = it >> 3, ch = it & 7, mk = (nb - 1) * 128 + kk;
        u32x4 kv = {0u, 0u, 0u, 0u}, vv = {0u, 0u, 0u, 0u};
        if (mk >= 0) { const bf16* src = PROJ + (rowbase + (size_t)(mk * dil + c)) * NPROJ + h * 64 + ch * 8; kv = *(const u32x4*)(src + C_KA); vv = *(const u32x4*)(src + C_VA); }
        *(LAS u32x4*)(lds + DA_K + kk * DA_KP + ch * 16) = kv;
        LAS unsigned short* vt = (LAS unsigned short*)(lds + DA_V + (ch * 8) * DA_VP + kk * 2);
        vt[0 * (DA_VP / 2)] = (unsigned short)(vv.x & 0xffffu); vt[1 * (DA_VP / 2)] = (unsigned short)(vv.x >> 16);
        vt[2 * (DA_VP / 2)] = (unsigned short)(vv.y & 0xffffu); vt[3 * (DA_VP / 2)] = (unsigned short)(vv.y >> 16);
        vt[4 * (DA_VP / 2)] = (unsigned short)(vv.z & 0xffffu); vt[5 * (DA_VP / 2)] = (unsigned short)(vv.z >> 16);
        vt[6 * (DA_VP / 2)] = (unsigned short)(vv.w & 0xffffu); vt[7 * (DA_VP / 2)] = (unsigned short)(vv.w >> 16);
    }
    const int qi = wave * 16 + fr, posq = (nb * 128 + qi) * dil + c;
    const size_t qrow = rowbase + posq;
    bf16x8 qf[2];
#pragma unroll
    for (int ks = 0; ks < 2; ++ks) qf[ks] = __builtin_bit_cast(bf16x8, *(const u32x4*)(PROJ + qrow * NPROJ + C_QA + h * 64 + ks * 32 + fq * 8));
    __syncthreads();
    f32x4 s[9]; float mx = -1e30f;
#pragma unroll
    for (int n = 0; n < 9; ++n) {
        f32x4 acc = {0.f, 0.f, 0.f, 0.f}; const int kb = wave + n;
#pragma unroll
        for (int ks = 0; ks < 2; ++ks) { const bf16x8 X = *(const LAS bf16x8*)(lds + DA_K + (kb * 16 + fr) * DA_KP + (ks * 32 + fq * 8) * 2); acc = MFMA16(X, qf[ks], acc); }
#pragma unroll
        for (int r = 0; r < 4; ++r) {
            const int dist = fr + 128 - 16 * n - 4 * fq - r, kk = 16 * kb + 4 * fq + r;
            const bool valid = (dist >= 0) && (dist <= 128) && (nb > 0 || kk >= 128);
            const int dc = dist < 0 ? 0 : (dist > 128 ? 128 : dist);
            const float v = valid ? acc[r] * 0.125f + biasl[dc] : -1e30f;
            acc[r] = v; mx = fmaxf(mx, v);
        }
        s[n] = acc;
    }
    mx = fmaxf(mx, __shfl_xor(mx, 16)); mx = fmaxf(mx, __shfl_xor(mx, 32));
    float l = 0.f;
#pragma unroll
    for (int n = 0; n < 9; ++n)
#pragma unroll
        for (int r = 0; r < 4; ++r) { const float e = __expf(s[n][r] - mx); s[n][r] = e; l += e; }
    l += __shfl_xor(l, 16); l += __shfl_xor(l, 32);
    bf16x8 pf[5];
#pragma unroll
    for (int st = 0; st < 4; ++st) { u32x4 w; w.x = pk2(s[2 * st][0], s[2 * st][1]); w.y = pk2(s[2 * st][2], s[2 * st][3]); w.z = pk2(s[2 * st + 1][0], s[2 * st + 1][1]); w.w = pk2(s[2 * st + 1][2], s[2 * st + 1][3]); pf[st] = __builtin_bit_cast(bf16x8, w); }
    { u32x4 w; w.x = pk2(s[8][0], s[8][1]); w.y = pk2(s[8][2], s[8][3]); w.z = 0u; w.w = 0u; pf[4] = __builtin_bit_cast(bf16x8, w); }
    const float inv = 1.f / l;
#pragma unroll
    for (int nn = 0; nn < 4; ++nn) {
        f32x4 acc = {0.f, 0.f, 0.f, 0.f};
#pragma unroll
        for (int st = 0; st < 5; ++st) {
            const int kb0 = wave + 2 * st, kb1 = st < 4 ? kb0 + 1 : kb0;
            const u32x2 lo = *(const LAS u32x2*)(lds + DA_V + (16 * nn + fr) * DA_VP + (kb0 * 16 + 4 * fq) * 2);
            const u32x2 hi = *(const LAS u32x2*)(lds + DA_V + (16 * nn + fr) * DA_VP + (kb1 * 16 + 4 * fq) * 2);
            const u32x4 xw = {lo.x, lo.y, hi.x, hi.y};
            acc = MFMA16(__builtin_bit_cast(bf16x8, xw), pf[st], acc);
        }
        u32x2 o; o.x = pk2(acc[0] * inv, acc[1] * inv); o.y = pk2(acc[2] * inv, acc[3] * inv);
        *(u32x2*)(OP + ((size_t)p * NTOK + qrow) * 512 + h * 64 + 16 * nn + 4 * fq) = o;
    }
    if (fq == 0) LSE[((size_t)p * NTOK + qrow) * 8 + h] = mx + __logf(l);
    __syncthreads();
}

constexpr int ML_P = 272;
constexpr int ML_T0 = 0, ML_T1 = 128 * ML_P, ML_T2 = 2 * 128 * ML_P, ML_ARR = 3 * 128 * ML_P;
__device__ __forceinline__ void conv4_silu8(const Args& a, int l, const bf16* PROJ, size_t seqrow0, int t, int col0, int chan0, float scale, float* y) {
    const float* cw = a.mconv_w + (size_t)l * 4 * 1024 + chan0; const float* cb = a.mconv_b + (size_t)l * 1024 + chan0;
    { const f32x4 b0 = *(const f32x4*)cb, b1 = *(const f32x4*)(cb + 4); y[0] = b0[0]; y[1] = b0[1]; y[2] = b0[2]; y[3] = b0[3]; y[4] = b1[0]; y[5] = b1[1]; y[6] = b1[2]; y[7] = b1[3]; }
#pragma unroll
    for (int j = 0; j < 4; ++j) { const int tt = t - 3 + j;
        if (tt >= 0) { float xv[8]; unpack8(*(const u32x4*)(PROJ + (seqrow0 + tt) * NPROJ + col0), xv);
            const f32x4 w0 = *(const f32x4*)(cw + j * 1024), w1 = *(const f32x4*)(cw + j * 1024 + 4);
#pragma unroll
            for (int i = 0; i < 4; ++i) { y[i] += w0[i] * xv[i]; y[4 + i] += w1[i] * xv[4 + i]; } } }
#pragma unroll
    for (int i = 0; i < 8; ++i) y[i] = y[i] * sigmoidf_(y[i]) * scale;
}
__device__ __forceinline__ void lds_store_T8(ldsp base, int row0, int col, const float* y) {
#pragma unroll
    for (int i = 0; i < 8; i += 2) { const unsigned w = pk2(y[i], y[i + 1]);
        *(LAS unsigned short*)(base + (row0 + i) * ML_P + col * 2) = (unsigned short)(w & 0xffffu); *(LAS unsigned short*)(base + (row0 + i + 1) * ML_P + col * 2) = (unsigned short)(w >> 16); }
}

__device__ __forceinline__ void m1_unit(const Args& a, int l, ldsp lds, int u) {
    int tid_ = threadIdx.x; asm volatile("" : "+v"(tid_)); const int tid = tid_, lane = tid & 63, wave = __builtin_amdgcn_readfirstlane(tid >> 6), fr = lane & 15, fq = lane >> 4;
    const int bh = u >> 5, c = u & 31, b = bh >> 2, h = bh & 3;
    const bf16* PROJ = (const bf16*)(a.ws + WS_PROJ);
    const size_t seqrow0 = (size_t)b * SEQ; const int t0 = c * 128;
    LAS float* lf = (LAS float*)(lds + ML_ARR); LAS float* igs = lf + 128; LAS float* bc = lf + 256; LAS float* wl = lf + 384; LAS float* wt = lf + 512;
    if (tid < 128) { const size_t row = seqrow0 + t0 + tid;
        igs[tid] = bf2f(PROJ[row * NPROJ + C_IG + h]) + a.b_ig[l * 4 + h]; lf[tid] = log_sigmoid(bf2f(PROJ[row * NPROJ + C_FG + h]) + a.b_fg[l * 4 + h]); }
    __syncthreads();
    if (tid < 128) { float s = 0.f; for (int i = 0; i <= tid; ++i) s += lf[i]; bc[tid] = s; }
    __syncthreads();
    const float g = bc[127];
    if (tid < 128) wl[tid] = g - bc[tid] + igs[tid];
    __syncthreads();
    float mloc = -1e30f; for (int i = 0; i < 128; ++i) mloc = fmaxf(mloc, wl[i]);
    if (tid < 128) wt[tid] = __expf(wl[tid] - mloc);
    __syncthreads();
    for (int it = tid; it < 2048; it += NTHR) {
        const int s = it >> 4, ch = it & 15; float y[8];
        conv4_silu8(a, l, PROJ, seqrow0, t0 + s, C_KM + h * 128 + ch * 8, 512 + h * 128 + ch * 8, 0.08838834764831845f, y);
        lds_store_T8(lds + ML_T0, ch * 8, s, y);
        unpack8(*(const u32x4*)(PROJ + (seqrow0 + t0 + s) * NPROJ + C_VM + h * 128 + ch * 8), y);
        const float w = wt[s];
#pragma unroll
        for (int i = 0; i < 8; ++i) y[i] *= w;
        lds_store_T8(lds + ML_T1, ch * 8, s, y);
    }
    __syncthreads();
    float* dC = (float*)(a.ws + WS_DC) + (size_t)u * 16384;
    bf16x8 xv[4];
#pragma unroll
    for (int ks = 0; ks < 4; ++ks) xv[ks] = *(const LAS bf16x8*)(lds + ML_T1 + (16 * wave + fr) * ML_P + (32 * ks + 8 * fq) * 2);
#pragma unroll
    for (int n = 0; n < 8; ++n) {
        f32x4 acc = {0.f, 0.f, 0.f, 0.f};
#pragma unroll
        for (int ks = 0; ks < 4; ++ks) { const bf16x8 Y = *(const LAS bf16x8*)(lds + ML_T0 + (16 * n + fr) * ML_P + (32 * ks + 8 * fq) * 2); acc = MFMA16(xv[ks], Y, acc); }
#pragma unroll
        for (int r = 0; r < 4; ++r) dC[(16 * wave + 4 * fq + r) * 128 + 16 * n + fr] = acc[r];
    }
    float* sm = (float*)(a.ws + WS_SMALL);
    if (tid < 128) { float s = 0.f; for (int i = 0; i < 128; ++i) s += wt[i] * bf2f(*(const LAS unsigned short*)(lds + ML_T0 + tid * ML_P + i * 2)); sm[SM_DN + u * 128 + tid] = s; }
    if (tid == 0) { sm[SM_MLOC + u] = mloc; sm[SM_GS + u] = g; }
    __syncthreads();
}

__device__ __forceinline__ void m2_scan(const Args& a, int gtid, int nthreads) {
    float* sm = (float*)(a.ws + WS_SMALL);
    const float* dC = (const float*)(a.ws + WS_DC); bf16* CP = (bf16*)(a.ws + WS_CP);
    for (int idx = gtid; idx < 16 * 16384 + 16 * 128; idx += nthreads) {
        const bool isn = idx >= 16 * 16384; const int id2 = isn ? idx - 16 * 16384 : idx;
        const int bh = isn ? (id2 >> 7) : (id2 >> 14), e = isn ? (id2 & 127) : (id2 & 16383);
        float m = 0.f, v = 0.f;
        for (int c = 0; c < 32; ++c) {
            const int u = bh * 32 + c;
            const float g = sm[SM_GS + u], ml = sm[SM_MLOC + u];
            float d;
            if (isn) { sm[SM_NP + u * 128 + e] = v; if (e == 0) sm[SM_MP + u] = m; d = sm[SM_DN + u * 128 + e]; }
            else { CP[(size_t)u * 16384 + e] = (bf16)(pk2(v, 0.f) & 0xffffu); d = dC[(size_t)u * 16384 + e]; }
            const float mn = fmaxf(g + m, ml);
            v = __expf(g + m - mn) * v + __expf(ml - mn) * d; m = mn;
        }
    }
}

__device__ __forceinline__ void m3_unit(const Args& a, int l, ldsp lds, int u) {
    int tid_ = threadIdx.x; asm volatile("" : "+v"(tid_)); const int tid = tid_, lane = tid & 63, wave = __builtin_amdgcn_readfirstlane(tid >> 6), fr = lane & 15, fq = lane >> 4;
    const int bh = u >> 5, c = u & 31, b = bh >> 2, h = bh & 3;
    const bf16* PROJ = (const bf16*)(a.ws + WS_PROJ);
    const size_t seqrow0 = (size_t)b * SEQ; const int t0 = c * 128;
    const float* sm = (const float*)(a.ws + WS_SMALL);
    LAS float* lf = (LAS float*)(lds + ML_ARR); LAS float* igs = lf + 128; LAS float* bc = lf + 256; LAS float* ev = lf + 384; LAS float* mxv = lf + 512; LAS float* npl = lf + 640;
    const float mP = sm[SM_MP + u];
    if (tid < 128) { const size_t row = seqrow0 + t0 + tid;
        igs[tid] = bf2f(PROJ[row * NPROJ + C_IG + h]) + a.b_ig[l * 4 + h]; lf[tid] = log_sigmoid(bf2f(PROJ[row * NPROJ + C_FG + h]) + a.b_fg[l * 4 + h]);
        npl[tid] = sm[SM_NP + u * 128 + tid]; }
    __syncthreads();
    if (tid < 128) { float s = 0.f; for (int i = 0; i <= tid; ++i) s += lf[i]; bc[tid] = s; ev[tid] = igs[tid] - s; }
    __syncthreads();
    if (tid < 128) { float m = mP; for (int i = 0; i <= tid; ++i) m = fmaxf(m, ev[i]); mxv[tid] = m; }
    for (int it = tid; it < 2048; it += NTHR) {
        const int s = it >> 4, ch = it & 15; float y[8];
        conv4_silu8(a, l, PROJ, seqrow0, t0 + s, C_QM + h * 128 + ch * 8, h * 128 + ch * 8, 1.f, y);
        *(LAS u32x4*)(lds + ML_T0 + s * ML_P + ch * 16) = pack8(y);
        conv4_silu8(a, l, PROJ, seqrow0, t0 + s, C_KM + h * 128 + ch * 8, 512 + h * 128 + ch * 8, 0.08838834764831845f, y);
        *(LAS u32x4*)(lds + ML_T1 + s * ML_P + ch * 16) = pack8(y);
        unpack8(*(const u32x4*)(PROJ + (seqrow0 + t0 + s) * NPROJ + C_VM + h * 128 + ch * 8), y);
        lds_store_T8(lds + ML_T2, ch * 8, s, y);
    }
    __syncthreads();
    const int t = 16 * wave + fr;
    bf16x8 qf[4];
#pragma unroll
    for (int ks = 0; ks < 4; ++ks) qf[ks] = *(const LAS bf16x8*)(lds + ML_T0 + t * ML_P + (32 * ks + 8 * fq) * 2);
    const float mx_t = mxv[t];
    f32x4 s[8]; float rs = 0.f;
#pragma unroll
    for (int n = 0; n < 8; ++n) {
        f32x4 acc = {0.f, 0.f, 0.f, 0.f};
        if (n <= wave) {
#pragma unroll
            for (int ks = 0; ks < 4; ++ks) { const bf16x8 X = *(const LAS bf16x8*)(lds + ML_T1 + (16 * n + fr) * ML_P + (32 * ks + 8 * fq) * 2); acc = MFMA16(X, qf[ks], acc); }
#pragma unroll
            for (int r = 0; r < 4; ++r) { const int si = 16 * n + 4 * fq + r; const float pv = (si <= t) ? __expf(ev[si] - mx_t) * acc[r] : 0.f; acc[r] = pv; rs += pv; }
        }
        s[n] = acc;
    }
    rs += __shfl_xor(rs, 16); rs += __shfl_xor(rs, 32);
    float nq = 0.f;
#pragma unroll
    for (int ks = 0; ks < 4; ++ks) { float qv[8]; unpack8(__builtin_bit_cast(u32x4, qf[ks]), qv);
#pragma unroll
        for (int i = 0; i < 8; ++i) nq += qv[i] * npl[32 * ks + 8 * fq + i]; }
    nq += __shfl_xor(nq, 16); nq += __shfl_xor(nq, 32);
    const float inter = __expf(mP - mx_t);
    const float den = inter * nq + rs, m_t = bc[t] + mx_t;
    const float inv = 1.f / fmaxf(fabsf(den), __expf(-m_t));
    bf16x8 pf[4];
#pragma unroll
    for (int st = 0; st < 4; ++st) { u32x4 w; w.x = pk2(s[2 * st][0], s[2 * st][1]); w.y = pk2(s[2 * st][2], s[2 * st][3]); w.z = pk2(s[2 * st + 1][0], s[2 * st + 1][1]); w.w = pk2(s[2 * st + 1][2], s[2 * st + 1][3]); pf[st] = __builtin_bit_cast(bf16x8, w); }
    const bf16* CPu = (const bf16*)(a.ws + WS_CP) + (size_t)u * 16384;
    bf16* HM = (bf16*)(a.ws + WS_HM);
    const size_t row = seqrow0 + t0 + t;
#pragma unroll
    for (int nn = 0; nn < 8; ++nn) {
        f32x4 acc = {0.f, 0.f, 0.f, 0.f};
#pragma unroll
        for (int ks = 0; ks < 4; ++ks) { const bf16x8 X = __builtin_bit_cast(bf16x8, *(const u32x4*)(CPu + (16 * nn + fr) * 128 + 32 * ks + 8 * fq)); acc = MFMA16(X, qf[ks], acc); }
#pragma unroll
        for (int r = 0; r < 4; ++r) acc[r] *= inter;
#pragma unroll
        for (int st = 0; st < 4; ++st) if (2 * st <= wave) {
            const u32x2 lo = *(const LAS u32x2*)(lds + ML_T2 + (16 * nn + fr) * ML_P + (32 * st + 4 * fq) * 2);
            const u32x2 hi = *(const LAS u32x2*)(lds + ML_T2 + (16 * nn + fr) * ML_P + (32 * st + 16 + 4 * fq) * 2);
            const u32x4 xw = {lo.x, lo.y, hi.x, hi.y};
            acc = MFMA16(__builtin_bit_cast(bf16x8, xw), pf[st], acc);
        }
        const u32x2 omw = *(const u32x2*)(PROJ + row * NPROJ + C_OM + h * 128 + 16 * nn + 4 * fq);
        const float o0 = acc[0] * inv * sigmoidf_(bflo(omw.x)), o1 = acc[1] * inv * sigmoidf_(bfhi(omw.x)), o2 = acc[2] * inv * sigmoidf_(bflo(omw.y)), o3 = acc[3] * inv * sigmoidf_(bfhi(omw.y));
        u32x2 o; o.x = pk2(o0, o1); o.y = pk2(o2, o3);
        *(u32x2*)(HM + row * 512 + h * 128 + 16 * nn + 4 * fq) = o;
    }
    __syncthreads();
}

__device__ __forceinline__ void mix_pass(const Args& a, int l, int gw, int NGW, int lane) {
    const bf16* OP = (const bf16*)(a.ws + WS_OP); const float* LSE = (const float*)(a.ws + WS_LSE); const bf16* HM = (const bf16*)(a.ws + WS_HM);
    bf16* MIXED = (bf16*)(a.ws + WS_MIXED);
    const float* ga = a.attn_out_g + (size_t)l * 512 + lane * 8; const float* gm = a.mlstm_out_g + (size_t)l * 512 + lane * 8;
    const int hd = lane >> 3;
    for (int m = gw; m < NTOK; m += NGW) {
        const float l0 = LSE[((size_t)0 * NTOK + m) * 8 + hd], l1 = LSE[((size_t)1 * NTOK + m) * 8 + hd], l2 = LSE[((size_t)2 * NTOK + m) * 8 + hd];
        const float lm = fmaxf(l0, fmaxf(l1, l2)); float w0 = __expf(l0 - lm), w1 = __expf(l1 - lm), w2 = __expf(l2 - lm); const float wi = 1.f / (w0 + w1 + w2); w0 *= wi; w1 *= wi; w2 *= wi;
        float o0[8], o1[8], o2[8], at[8];
        unpack8(*(const u32x4*)(OP + ((size_t)0 * NTOK + m) * 512 + lane * 8), o0); unpack8(*(const u32x4*)(OP + ((size_t)1 * NTOK + m) * 512 + lane * 8), o1); unpack8(*(const u32x4*)(OP + ((size_t)2 * NTOK + m) * 512 + lane * 8), o2);
        float ss = 0.f;
#pragma unroll
        for (int i = 0; i < 8; ++i) { at[i] = w0 * o0[i] + w1 * o1[i] + w2 * o2[i]; ss += at[i] * at[i]; }
        const float ra = rsqrtf(wave_sum(ss) * (1.f / 512.f) + EPS);
        { const f32x4 g0 = *(const f32x4*)ga, g1 = *(const f32x4*)(ga + 4);
#pragma unroll
          for (int i = 0; i < 4; ++i) { at[i] *= ra * g0[i]; at[4 + i] *= ra * g1[i]; } }
        *(u32x4*)(MIXED + (size_t)m * DM + lane * 8) = pack8(at);
        float hv[8]; unpack8(*(const u32x4*)(HM + (size_t)m * 512 + lane * 8), hv);
        float hs = 0.f;
#pragma unroll
        for (int i = 0; i < 8; ++i) hs += hv[i] * hv[i];
        const float rh = rsqrtf(wave_sum(hs) * (1.f / 512.f) + EPS);
        { const f32x4 g0 = *(const f32x4*)gm, g1 = *(const f32x4*)(gm + 4);
#pragma unroll
          for (int i = 0; i < 4; ++i) { hv[i] *= rh * g0[i]; hv[4 + i] *= rh * g1[i]; } }
        *(u32x4*)(MIXED + (size_t)m * DM + 512 + lane * 8) = pack8(hv);
    }
}

constexpr int XA_P = 528;
__device__ __forceinline__ void xa_unit(const Args& a, int l, ldsp lds, int u) {
    int tid_ = threadIdx.x; asm volatile("" : "+v"(tid_)); const int tid = tid_, lane = tid & 63, wave = __builtin_amdgcn_readfirstlane(tid >> 6), fr = lane & 15, fq = lane >> 4;
    const int bh = u >> 5, qb = u & 31, b = bh >> 2, h = bh & 3;
    const bf16* Q = (const bf16*)(a.ws + WS_Q); bf16* O = (bf16*)(a.ws + WS_O);
    const bf16* KM = (const bf16*)(a.ws + WS_KM); const bf16* VT = (const bf16*)(a.ws + WS_VT);
    const size_t row = (size_t)b * SEQ + qb * 128 + wave * 16 + fr;
    for (int it = tid; it < 8192; it += NTHR) { const int key = it >> 5, ch = it & 31;
        *(LAS u32x4*)(lds + key * XA_P + ch * 16) = *(const u32x4*)(KM + (size_t)(b * NMEM + key) * 4096 + l * 1024 + h * 256 + ch * 8); }
    bf16x8 qf[8];
#pragma unroll
    for (int ks = 0; ks < 8; ++ks) qf[ks] = __builtin_bit_cast(bf16x8, *(const u32x4*)(Q + row * DM + h * 256 + ks * 32 + fq * 8));
    __syncthreads();
    f32x4 s[16]; float mx = -1e30f;
#pragma unroll
    for (int n = 0; n < 16; ++n) {
        f32x4 acc = {0.f, 0.f, 0.f, 0.f};
#pragma unroll
        for (int ks = 0; ks < 8; ++ks) { const bf16x8 X = *(const LAS bf16x8*)(lds + (16 * n + fr) * XA_P + (32 * ks + 8 * fq) * 2); acc = MFMA16(X, qf[ks], acc); }
#pragma unroll
        for (int r = 0; r < 4; ++r) { acc[r] *= 0.0625f; mx = fmaxf(mx, acc[r]); }
        s[n] = acc;
    }
    mx = fmaxf(mx, __shfl_xor(mx, 16)); mx = fmaxf(mx, __shfl_xor(mx, 32));
    float lsum = 0.f;
#pragma unroll
    for (int n = 0; n < 16; ++n)
#pragma unroll
        for (int r = 0; r < 4; ++r) { const float e = __expf(s[n][r] - mx); s[n][r] = e; lsum += e; }
    lsum += __shfl_xor(lsum, 16); lsum += __shfl_xor(lsum, 32);
    const float inv = 1.f / lsum;
    bf16x8 pf[8];
#pragma unroll
    for (int st = 0; st < 8; ++st) { u32x4 w; w.x = pk2(s[2 * st][0], s[2 * st][1]); w.y = pk2(s[2 * st][2], s[2 * st][3]); w.z = pk2(s[2 * st + 1][0], s[2 * st + 1][1]); w.w = pk2(s[2 * st + 1][2], s[2 * st + 1][3]); pf[st] = __builtin_bit_cast(bf16x8, w); }
    __syncthreads();
    for (int it = tid; it < 8192; it += NTHR) { const int d = it >> 5, ch = it & 31;
        *(LAS u32x4*)(lds + d * XA_P + ch * 16) = *(const u32x4*)(VT + (size_t)(l * 1024 + h * 256 + d) * NMEMROWS + b * NMEM + ch * 8); }
    __syncthreads();
#pragma unroll
    for (int nn = 0; nn < 16; ++nn) {
        f32x4 acc = {0.f, 0.f, 0.f, 0.f};
#pragma unroll
        for (int st = 0; st < 8; ++st) {
            const u32x2 lo = *(const LAS u32x2*)(lds + (16 * nn + fr) * XA_P + (32 * st + 4 * fq) * 2);
            const u32x2 hi = *(const LAS u32x2*)(lds + (16 * nn + fr) * XA_P + (32 * st + 16 + 4 * fq) * 2);
            const u32x4 xw = {lo.x, lo.y, hi.x, hi.y};
            acc = MFMA16(__builtin_bit_cast(bf16x8, xw), pf[st], acc);
        }
        u32x2 o; o.x = pk2(acc[0] * inv, acc[1] * inv); o.y = pk2(acc[2] * inv, acc[3] * inv);
        *(u32x2*)(O + row * DM + h * 256 + 16 * nn + 4 * fq) = o;
    }
    __syncthreads();
}

__device__ __forceinline__ float gelu_tanh(float x) { const float z = 0.7978845608028654f * (x + 0.044715f * x * x * x); const float t = 1.f - 2.f / (__expf(2.f * z) + 1.f); return 0.5f * x * (1.f + t); }
__device__ __forceinline__ void cg_item(const Args& a, int l, int item) {
    int tid_ = threadIdx.x; asm volatile("" : "+v"(tid_)); const int tid = tid_; if (tid >= 352) return;
    const bf16* U = (const bf16*)(a.ws + WS_UR); bf16* G = (bf16*)(a.ws + WS_GR);
    const int r0 = item * 32, t0 = r0 & (SEQ - 1), c0 = tid * 8;
    const float* fw = a.fconv_w + (size_t)l * 3 * DFF2; const float* fb = a.fconv_b + (size_t)l * DFF2;
    float wa[3][8], wg[3][8], ba[8], bg[8];
#pragma unroll
    for (int j = 0; j < 3; ++j) { const f32x4 p0 = *(const f32x4*)(fw + j * DFF2 + c0), p1 = *(const f32x4*)(fw + j * DFF2 + c0 + 4), q0 = *(const f32x4*)(fw + j * DFF2 + DFF + c0), q1 = *(const f32x4*)(fw + j * DFF2 + DFF + c0 + 4);
#pragma unroll
        for (int i = 0; i < 4; ++i) { wa[j][i] = p0[i]; wa[j][4 + i] = p1[i]; wg[j][i] = q0[i]; wg[j][4 + i] = q1[i]; } }
    { const f32x4 p0 = *(const f32x4*)(fb + c0), p1 = *(const f32x4*)(fb + c0 + 4), q0 = *(const f32x4*)(fb + DFF + c0), q1 = *(const f32x4*)(fb + DFF + c0 + 4);
#pragma unroll
      for (int i = 0; i < 4; ++i) { ba[i] = p0[i]; ba[4 + i] = p1[i]; bg[i] = q0[i]; bg[4 + i] = q1[i]; } }
    float a1[8], a2[8], g1[8], g2[8];
#pragma unroll
    for (int i = 0; i < 8; ++i) { a1[i] = 0.f; a2[i] = 0.f; g1[i] = 0.f; g2[i] = 0.f; }
    if (t0 > 0) { unpack8(*(const u32x4*)(U + (size_t)(r0 - 1) * DFF2 + c0), a1); unpack8(*(const u32x4*)(U + (size_t)(r0 - 1) * DFF2 + DFF + c0), g1);
                  unpack8(*(const u32x4*)(U + (size_t)(r0 - 2) * DFF2 + c0), a2); unpack8(*(const u32x4*)(U + (size_t)(r0 - 2) * DFF2 + DFF + c0), g2); }
    for (int rr = 0; rr < 32; rr += 4) {
        u32x4 ua[4], ug[4];
#pragma unroll
        for (int k = 0; k < 4; ++k) { ua[k] = *(const u32x4*)(U + (size_t)(r0 + rr + k) * DFF2 + c0); ug[k] = *(const u32x4*)(U + (size_t)(r0 + rr + k) * DFF2 + DFF + c0); }
#pragma unroll
        for (int k = 0; k < 4; ++k) {
            float a0[8], g0[8], o[8]; unpack8(ua[k], a0); unpack8(ug[k], g0);
#pragma unroll
            for (int i = 0; i < 8; ++i) { const float av = ba[i] + wa[0][i] * a2[i] + wa[1][i] * a1[i] + wa[2][i] * a0[i]; const float gv = bg[i] + wg[0][i] * g2[i] + wg[1][i] * g1[i] + wg[2][i] * g0[i];
                o[i] = gelu_tanh(gv) * av; a2[i] = a1[i]; a1[i] = a0[i]; g2[i] = g1[i]; g1[i] = g0[i]; }
            *(u32x4*)(G + (size_t)(r0 + rr + k) * DFF + c0) = pack8(o);
        }
    }
}


#ifdef SKIP_M1
#define SK_M1(x)
#else
#define SK_M1(x) x
#endif
#ifdef SKIP_DA
#define SK_DA(x)
#else
#define SK_DA(x) x
#endif
#ifdef SKIP_M2
#define SK_M2(x)
#else
#define SK_M2(x) x
#endif
#ifdef SKIP_M3
#define SK_M3(x)
#else
#define SK_M3(x) x
#endif
#ifdef SKIP_MIX
#define SK_MIX(x)
#else
#define SK_MIX(x) x
#endif
#ifdef SKIP_XA
#define SK_XA(x)
#else
#define SK_XA(x) x
#endif
#ifdef SKIP_CG
#define SK_CG(x)
#else
#define SK_CG(x) x
#endif
constexpr int N_PHASES = 2 + 15 * DEPTH;
__global__ void __launch_bounds__(NTHR, 2) mk_fwd(Args a) {
    extern __shared__ __attribute__((aligned(16))) unsigned char lds_raw[];
    const ldsp lds = (ldsp)lds_raw;
    volatile LAS unsigned* MISC = (volatile LAS unsigned*)(lds + MISC_OFF);
    const int G = gridDim.x, bid = blockIdx.x;
    unsigned char* ws = a.ws;
    if (threadIdx.x < 64) MISC[threadIdx.x] = 0u;
    __syncthreads();
    XcdBarrier bar; bar.bar = (unsigned*)(ws + WS_CTL) + CW_BAR; bar.x = 0; bar.st = nullptr;
    const bool multi = (a.ph_hi - a.ph_lo) > 1;
    if (multi) bar = xcd_barrier_post((unsigned*)(ws + WS_CTL) + CW_BAR, MISC + 8);
    cg::grid_group grid = cg::this_grid();

#ifdef SINGLE_PH
    { const int ph = a.ph_lo;
#else
    for (int ph = a.ph_lo; ph < a.ph_hi; ++ph) {
#endif
        int tidl = threadIdx.x; asm volatile("" : "+v"(tidl));
        const int tid = tidl, lane = tid & 63, wave = __builtin_amdgcn_readfirstlane(tid >> 6);
        const int gw = bid * NWAVES + wave, NGW = G * NWAVES;
        if (ph == 0) {
            convert_layer_weights(a, 0, lds, gw, NGW, wave, lane);
            LAS float* scr = (LAS float*)(lds + wave * 16384);
            constexpr int I_SQ = (DM / 64) * (DM / 32);
            for (int it = gw; it < 8 * I_SQ; it += NGW) { const int mtx = it / I_SQ, r = it % I_SQ, l = mtx >> 1;
                if ((mtx & 1) == 0) transpose_item(a.wk + (size_t)l * DM * DM, DM, DM, DM, (bf16*)(ws + WS_WKT) + (size_t)l * DM * DM, scr, r, lane);
                else transpose_item(a.wv + (size_t)l * DM * DM, DM, DM, DM, (bf16*)(ws + WS_WVT) + (size_t)l * DM * DM, scr, r, lane); }
            for (int i = bid * NTHR + tid; i < NMEMROWS * DM / 8; i += G * NTHR) { const f32x4 v0 = *(const f32x4*)(a.mem + (size_t)i * 8), v1 = *(const f32x4*)(a.mem + (size_t)i * 8 + 4);
                u32x4 w; w.x = pk2(v0[0], v0[1]); w.y = pk2(v0[2], v0[3]); w.z = pk2(v1[0], v1[1]); w.w = pk2(v1[2], v1[3]); *(u32x4*)((bf16*)(ws + WS_MEMB) + (size_t)i * 8) = w; }
            row_pass(nullptr, a.x, nullptr, nullptr, a.pre_mix_g, (bf16*)(ws + WS_XN), gw, NGW, lane);
        }
#ifndef SKIP_KV
        else if (ph == 1) {
            { pg8::Gemm g{(const bf16*)(ws + WS_MEMB), (const bf16*)(ws + WS_WKT), NMEMROWS, 4096, DM}; pg8::StaticOrder S; S.init(NMEMROWS, 4096, G, bid);
              pg8::EpiBf16 E{(bf16*)(ws + WS_KM), 4096}; pg8::gemm_phase<pg8::EpiBf16, pg8::StaticOrder, true, true>(lds, g, S, E); }
            { pg8::Gemm g{(const bf16*)(ws + WS_WVT), (const bf16*)(ws + WS_MEMB), 4096, NMEMROWS, DM}; pg8::StaticOrder S; S.init(4096, NMEMROWS, G, (bid + G / 2) % G);
              pg8::EpiBf16 E{(bf16*)(ws + WS_VT), NMEMROWS}; pg8::gemm_phase<pg8::EpiBf16, pg8::StaticOrder, true, true>(lds, g, S, E); }
        }
#endif
        else {
            const int l = (ph - 2) / 15, st = (ph - 2) % 15;
            const bf16* gA = nullptr; const bf16* gB = nullptr; bf16* gO = nullptr; int gN = 0, gK = 0;
            switch (st) {
                case 0:  gA = (const bf16*)(ws + WS_XN);    gB = (const bf16*)(ws + WS_WIN);  gO = (bf16*)(ws + WS_PROJ); gN = NPROJ; gK = DM; break;
                case 5:  gA = (const bf16*)(ws + WS_MIXED); gB = (const bf16*)(ws + WS_WOUT); gO = (bf16*)(ws + WS_H);    gN = DM;    gK = DM; break;
                case 7:  gA = (const bf16*)(ws + WS_XN);    gB = (const bf16*)(ws + WS_WQ);   gO = (bf16*)(ws + WS_Q);    gN = DM;    gK = DM; break;
                case 9:  gA = (const bf16*)(ws + WS_O);     gB = (const bf16*)(ws + WS_WO);   gO = (bf16*)(ws + WS_H);    gN = DM;    gK = DM; break;
                case 11: gA = (const bf16*)(ws + WS_XN);    gB = (const bf16*)(ws + WS_WUP);  gO = (bf16*)(ws + WS_UR);   gN = DFF2;  gK = DM; break;
                case 13: gA = (const bf16*)(ws + WS_GR);    gB = (const bf16*)(ws + WS_WDN);  gO = (bf16*)(ws + WS_H);    gN = DM;    gK = DFF; break;
                default: break;
            }
            if (gA) {
                pg8::Gemm g{gA, gB, NTOK, gN, gK}; pg8::StaticOrder S; S.init(NTOK, gN, G, bid);
                pg8::EpiBf16 E{gO, gN}; pg8::gemm_phase<pg8::EpiBf16, pg8::StaticOrder, true, true>(lds, g, S, E);
            } else if (st == 1) {
                for (int u = bid; u < 512 + 3072; u += G) { if (u < 512) { SK_M1(m1_unit(a, l, lds, u)); } else { SK_DA(da_unit(a, lds, u - 512)); } }
            } else if (st == 2) {
                SK_M2(m2_scan(a, bid * NTHR + tid, G * NTHR));
            } else if (st == 3) {
                for (int u = bid; u < 512; u += G) { SK_M3(m3_unit(a, l, lds, u)); }
            } else if (st == 4) {
                SK_MIX(mix_pass(a, l, gw, NGW, lane));
            } else if (st == 6) {
                row_pass((const bf16*)(ws + WS_H), l == 0 ? a.x : a.out, a.out, a.post_mix_g + (size_t)l * DM, a.pre_mem_g + (size_t)l * DM, (bf16*)(ws + WS_XN), gw, NGW, lane);
            } else if (st == 8) {
                for (int u = bid; u < 512; u += G) { SK_XA(xa_unit(a, l, lds, u)); }
            } else if (st == 10) {
                row_pass((const bf16*)(ws + WS_H), a.out, a.out, a.post_mem_g + (size_t)l * DM, a.pre_ffn_g + (size_t)l * DM, (bf16*)(ws + WS_XN), gw, NGW, lane);
            } else if (st == 12) {
                for (int it = bid; it < NTOK / 32; it += G) { SK_CG(cg_item(a, l, it)); }
            } else if (st == 14) {
                const bool lastl = (l == DEPTH - 1);
                row_pass((const bf16*)(ws + WS_H), a.out, a.out, a.post_ffn_g + (size_t)l * DM, lastl ? nullptr : a.pre_mix_g + (size_t)(l + 1) * DM, lastl ? nullptr : (bf16*)(ws + WS_XN), gw, NGW, lane);
                if (!lastl) convert_layer_weights(a, l + 1, lds, gw, NGW, wave, lane);
            }
        }
        if (ph + 1 < a.ph_hi) { if (ph == a.ph_lo) grid.sync(); else xcd_barrier(bar); }
    }
}

extern "C" void kernel_launch(void* const* d_in, const int* in_sizes, int n_in, void* d_out, int out_size, void* d_ws, size_t ws_size, hipStream_t stream) {
    static int grid = 0;
    if (grid == 0) {
        if (n_in != 25 || out_size != NTOK * DM || ws_size < WS_END) { fprintf(stderr, "kernel_launch: unexpected shapes (n_in %d out %d ws %zu need %zu)\n", n_in, out_size, ws_size, (size_t)WS_END); grid = -1; return; }
        int dev = 0, cus = 0, per_cu = 0;
        hipGetDevice(&dev); hipDeviceGetAttribute(&cus, hipDeviceAttributeMultiprocessorCount, dev);
        hipFuncSetAttribute((const void*)mk_fwd, hipFuncAttributeMaxDynamicSharedMemorySize, LDS_BYTES);
        hipOccupancyMaxActiveBlocksPerMultiprocessor(&per_cu, (const void*)mk_fwd, NTHR, LDS_BYTES);
        (void)hipGetLastError();
        if (per_cu < 1) per_cu = 1;
        grid = cus * 1;
        if (grid <= 0) grid = 256;
    }
    if (grid < 0) return;
    hipMemsetAsync((char*)d_ws + WS_CTL, 0, CTL_ZERO_BYTES, stream);
    Args a{};
    const float** ap = (const float**)&a;
    for (int i = 0; i < 25; ++i) ap[i] = (const float*)d_in[i];
    a.out = (float*)d_out; a.ws = (unsigned char*)d_ws;
#if MK_PER_PHASE_LAUNCH
    for (int ph = 0; ph < N_PHASES; ++ph) { a.ph_lo = ph; a.ph_hi = ph + 1; hipLaunchKernelGGL(mk_fwd, dim3(grid), dim3(NTHR), LDS_BYTES, stream, a); }
#else
    a.ph_lo = 0; a.ph_hi = N_PHASES;
    void* args[] = {&a};
    hipError_t e = hipLaunchCooperativeKernel((const void*)mk_fwd, dim3(grid), dim3(NTHR), args, LDS_BYTES, stream);
    if (e != hipSuccess) fprintf(stderr, "cooperative launch failed: %s (grid %d)\n", hipGetErrorString(e), grid);
#endif
}
```

```cpp
#include <hip/hip_runtime.h>
#include <hip/hip_cooperative_groups.h>
#include <cstdio>
#include <cstdint>
namespace cg = cooperative_groups;

#ifndef MK_PER_PHASE_LAUNCH
#define MK_PER_PHASE_LAUNCH 0
#endif

namespace pg8 {
#define PG8_LAS __attribute__((address_space(3)))
typedef unsigned short bf16_t;
typedef short bf16x8 __attribute__((ext_vector_type(8)));
typedef float f32x4 __attribute__((ext_vector_type(4)));
typedef unsigned u32x4 __attribute__((ext_vector_type(4)));
constexpr int BM = 256, BK = 64, HALF = 128, HTB = HALF * BK * 2, STAGE_BYTES = 8 * HTB, NXCD = 8, WGM = 8;

__host__ __device__ __forceinline__ int lds_byte(int r, int c) { const int st = (r >> 4) * 2 + (c >> 5), rr = r & 15, cc = c & 31, ob = rr * 64 + cc * 2; return st * 1024 + (ob ^ (((ob >> 9) & 1) << 5)); }
__host__ __device__ __forceinline__ void stage_rc(int b, int& R, int& C) { const int st = b / 1024, sb = b % 1024, swz = sb ^ (((sb >> 9) & 1) << 5); R = (st >> 1) * 16 + swz / 64; C = (st & 1) * 32 + (swz % 64) / 2; }
__host__ __device__ __forceinline__ int perm32(int rho) { const int n = rho >> 4, i = rho & 15; return 8 * (i >> 2) + 4 * n + (i & 3); }

struct Unit { int pm, pn; };
struct Gemm { const bf16_t* A; const bf16_t* Bt; int M, N, K; };

struct StaticOrder {
    int nM, nN, nwg, G, c;
    __host__ __device__ void init(int M, int N, int G_, int c_) { nM = M / BM; nN = N / BM; nwg = nM * nN; G = G_; c = c_; }
    __host__ __device__ bool next(int i, Unit& u) const {
        const long L = (long)i * G + c; if (L >= nwg) return false;
        int wgid = (int)L; { const int q = nwg / NXCD, r = nwg % NXCD, xcd = wgid % NXCD, off = wgid / NXCD; wgid = (xcd < r ? xcd * (q + 1) : r * (q + 1) + (xcd - r) * q) + off; }
        const int nig = WGM * nN, gid = wgid / nig, fm = gid * WGM, gsz = (nM - fm) < WGM ? (nM - fm) : WGM;
        u.pm = fm + ((wgid % nig) % gsz); u.pn = (wgid % nig) / gsz; return true;
    }
    __device__ __forceinline__ void a_ready(const Unit&) const {}
    __device__ __forceinline__ void done(const Unit&) const {}
};

__device__ __forceinline__ unsigned cvt_pk_bf16(float lo, float hi) { unsigned r; asm volatile("v_cvt_pk_bf16_f32 %0, %1, %2" : "=v"(r) : "v"(lo), "v"(hi)); return r; }

struct EpiBf16 {
    static constexpr bool PERM = true, AFTER_DRAIN = false;
    bf16_t* O; int ldc;
    __device__ __forceinline__ void operator()(const f32x4 (&acc)[2][2][4][2], const Unit& u, int wr, int wc, int fr, int fq) const {
        const int row0 = u.pm * BM + wr * 64 + fr; const int col0 = u.pn * BM + wc * 32 + 8 * fq;
#pragma unroll
        for (int ai = 0; ai < 2; ++ai)
#pragma unroll
            for (int m = 0; m < 4; ++m) { bf16_t* rowp = O + (size_t)(row0 + ai * HALF + m * 16) * ldc + col0;
#pragma unroll
                for (int bj = 0; bj < 2; ++bj) { const f32x4 v0 = acc[ai][bj][m][0], v1 = acc[ai][bj][m][1];
                    u32x4 w; w.x = cvt_pk_bf16(v0[0], v0[1]); w.y = cvt_pk_bf16(v0[2], v0[3]); w.z = cvt_pk_bf16(v1[0], v1[1]); w.w = cvt_pk_bf16(v1[2], v1[3]);
                    *(u32x4*)(rowp + bj * HALF) = w; } }
    }
};

template <class Epi, class Sched, bool ALIGN_EPI = false, bool SP2 = false>
__device__ __forceinline__ void gemm_phase(PG8_LAS unsigned char* lds, const Gemm g, const Sched& S, const Epi& E) {
    int tid_ = threadIdx.x; asm volatile("" : "+v"(tid_)); const int tid = tid_, wid = __builtin_amdgcn_readfirstlane(tid >> 6), lane = tid & 63, wr = wid >> 2, wc = wid & 3, fr = lane & 15, fq = lane >> 4;
    const int K = g.K, nt = K / BK;
    unsigned voffA[2], voffB[2];
#pragma unroll
    for (int i = 0; i < 2; ++i) { int R, C; stage_rc(tid * 16 + i * 8192, R, C); const int Rb = Epi::PERM ? ((R & ~31) + perm32(R & 31)) : R;
        voffA[i] = (unsigned)(R * K + C) * 2u; voffB[i] = (unsigned)(Rb * K + C) * 2u; }
    const size_t kstep = (size_t)(BK * 2);
    const size_t hstep = (size_t)HALF * K * 2;
    const size_t tstep = 2 * hstep;
    const unsigned ldsw = (unsigned)wid * 1024u;
    const int aoff = lds_byte(wr * 64 + fr, fq * 8), boff = lds_byte(wc * 32 + fr, fq * 8);
#define PG8_SA(b, h) (((b) * 2 + (h)) * HTB)
#define PG8_SB(b, h) ((4 + (b) * 2 + (h)) * HTB)
#define PG8_STAGE(bufoff, gbase, voff) do { _Pragma("unroll") for (int _i = 0; _i < 2; ++_i) \
        __builtin_amdgcn_global_load_lds((const unsigned*)((const char*)(gbase) + (voff)[_i]), (PG8_LAS unsigned*)(lds + (bufoff) + ldsw + _i * 8192), 16, 0, 0); } while (0)
#define PG8_LDA(dst, b, h) do { _Pragma("unroll") for (int m = 0; m < 4; ++m) _Pragma("unroll") for (int k = 0; k < 2; ++k) dst[m][k] = *(const PG8_LAS bf16x8*)(lds + PG8_SA(b, h) + aoff + m * 2048 + k * 1024); } while (0)
#define PG8_LDB(dst, b, h) do { _Pragma("unroll") for (int n = 0; n < 2; ++n) _Pragma("unroll") for (int k = 0; k < 2; ++k) dst[n][k] = *(const PG8_LAS bf16x8*)(lds + PG8_SB(b, h) + boff + n * 2048 + k * 1024); } while (0)
#define PG8_MMA(ai, bj, At, Bt) do { __builtin_amdgcn_s_setprio(1); _Pragma("unroll") for (int m = 0; m < 4; ++m) _Pragma("unroll") for (int n = 0; n < 2; ++n) _Pragma("unroll") for (int k = 0; k < 2; ++k) \
        acc[ai][bj][m][n] = __builtin_amdgcn_mfma_f32_16x16x32_bf16(Bt[n][k], At[m][k], acc[ai][bj][m][n], 0, 0, 0); __builtin_amdgcn_s_setprio(0); } while (0)
#define PG8_WAIT_V(n) asm volatile("s_waitcnt vmcnt(" #n ")" ::: "memory")
#define PG8_WAIT_L(n) asm volatile("s_waitcnt lgkmcnt(" #n ")" ::: "memory")
#define PG8_BAR __builtin_amdgcn_s_barrier()
#define PG8_SCHED __builtin_amdgcn_sched_barrier(0)
    Unit cur, nxt; int ui = 0;
    if (!S.next(0, cur)) return;
    f32x4 acc[2][2][4][2];
#pragma unroll
    for (int a = 0; a < 2; ++a)
#pragma unroll
        for (int b = 0; b < 2; ++b)
#pragma unroll
            for (int m = 0; m < 4; ++m)
#pragma unroll
                for (int n = 0; n < 2; ++n) acc[a][b][m][n] = (f32x4){0.f, 0.f, 0.f, 0.f};
    bf16x8 At[4][2], B0[2][2], B1[2][2];
    const char* cA = (const char*)g.A + (size_t)cur.pm * tstep; const char* cB = (const char*)g.Bt + (size_t)cur.pn * tstep;
    S.a_ready(cur);
    if constexpr (SP2) {
        PG8_STAGE(PG8_SB(0, 0), cB, voffB); PG8_STAGE(PG8_SB(0, 1), cB + hstep, voffB); PG8_STAGE(PG8_SA(0, 0), cA, voffA); PG8_STAGE(PG8_SA(0, 1), cA + hstep, voffA);
        if (wr == 1) PG8_BAR;
        PG8_WAIT_V(2); PG8_BAR;
        PG8_STAGE(PG8_SB(1, 0), cB + kstep, voffB); PG8_STAGE(PG8_SA(1, 0), cA + kstep, voffA); PG8_STAGE(PG8_SB(1, 1), cB + hstep + kstep, voffB);
        PG8_WAIT_V(6); PG8_BAR;
    } else {
        PG8_STAGE(PG8_SB(0, 0), cB, voffB); PG8_STAGE(PG8_SA(0, 0), cA, voffA); PG8_STAGE(PG8_SB(0, 1), cB + hstep, voffB); PG8_STAGE(PG8_SA(0, 1), cA + hstep, voffA);
        if (wr == 1) PG8_BAR;
        PG8_WAIT_V(4); PG8_BAR;
        PG8_STAGE(PG8_SB(1, 0), cB + kstep, voffB); PG8_STAGE(PG8_SA(1, 0), cA + kstep, voffA); PG8_STAGE(PG8_SB(1, 1), cB + hstep + kstep, voffB);
        PG8_WAIT_V(6); PG8_BAR;
    }
    for (;;) {
        const bool has_next = S.next(ui + 1, nxt);
        const char* nA = has_next ? (const char*)g.A + (size_t)nxt.pm * tstep : cA; const char* nB = has_next ? (const char*)g.Bt + (size_t)nxt.pn * tstep : cB;
        for (int t = 0; t < nt; t += 2) {
            const bool last = (t == nt - 2);
            const char* a1 = cA + (size_t)(t + 1) * kstep;
            const char* a2 = last ? nA : cA + (size_t)(t + 2) * kstep; const char* b2 = last ? nB : cB + (size_t)(t + 2) * kstep;
            const char* a3 = a2 + kstep; const char* b3 = b2 + kstep;
            if (last && has_next) S.a_ready(nxt);
            if constexpr (SP2) {
            PG8_LDB(B0, 0, 0); PG8_LDB(B1, 0, 1); PG8_SCHED; PG8_LDA(At, 0, 0); PG8_STAGE(PG8_SA(1, 1), a1 + hstep, voffA);
            PG8_WAIT_V(8); PG8_WAIT_L(0); PG8_BAR; PG8_MMA(0, 0, At, B0); PG8_MMA(0, 1, At, B1); PG8_BAR; PG8_SCHED;
            PG8_LDA(At, 0, 1); PG8_STAGE(PG8_SB(0, 0), b2, voffB); PG8_STAGE(PG8_SB(0, 1), b2 + hstep, voffB); PG8_STAGE(PG8_SA(0, 0), a2, voffA);
            PG8_WAIT_V(8); PG8_WAIT_L(0); PG8_BAR; PG8_MMA(1, 0, At, B0); PG8_MMA(1, 1, At, B1); PG8_BAR; PG8_SCHED;
            PG8_LDB(B0, 1, 0); PG8_LDB(B1, 1, 1); PG8_SCHED; PG8_LDA(At, 1, 0); PG8_STAGE(PG8_SA(0, 1), a2 + hstep, voffA);
            PG8_WAIT_V(8); PG8_WAIT_L(0); PG8_BAR; PG8_MMA(0, 0, At, B0); PG8_MMA(0, 1, At, B1); PG8_BAR; PG8_SCHED;
            PG8_LDA(At, 1, 1); PG8_STAGE(PG8_SB(1, 0), b3, voffB); PG8_STAGE(PG8_SB(1, 1), b3 + hstep, voffB); PG8_STAGE(PG8_SA(1, 0), a3, voffA);
            PG8_WAIT_V(8); PG8_WAIT_L(0); PG8_BAR; PG8_MMA(1, 0, At, B0); PG8_MMA(1, 1, At, B1); PG8_BAR; PG8_SCHED;
            } else {
            PG8_LDB(B0, 0, 0); PG8_SCHED; PG8_LDA(At, 0, 0); PG8_STAGE(PG8_SA(1, 1), a1 + hstep, voffA);
            PG8_WAIT_L(8); PG8_BAR; PG8_WAIT_L(0); PG8_MMA(0, 0, At, B0); PG8_BAR; PG8_SCHED;
            PG8_LDB(B1, 0, 1); PG8_STAGE(PG8_SB(0, 0), b2, voffB);
            PG8_BAR; PG8_WAIT_L(0); PG8_MMA(0, 1, At, B1); PG8_BAR;
            PG8_LDA(At, 0, 1); PG8_STAGE(PG8_SA(0, 0), a2, voffA);
            PG8_BAR; PG8_WAIT_L(0); PG8_MMA(1, 0, At, B0); PG8_BAR; PG8_SCHED;
            PG8_STAGE(PG8_SB(0, 1), b2 + hstep, voffB);
            PG8_WAIT_V(6); PG8_BAR; PG8_MMA(1, 1, At, B1); PG8_BAR;
            PG8_LDB(B0, 1, 0); PG8_SCHED; PG8_LDA(At, 1, 0); PG8_STAGE(PG8_SA(0, 1), a2 + hstep, voffA);
            PG8_WAIT_L(8); PG8_BAR; PG8_WAIT_L(0); PG8_MMA(0, 0, At, B0); PG8_BAR; PG8_SCHED;
            PG8_LDB(B1, 1, 1); PG8_STAGE(PG8_SB(1, 0), b3, voffB);
            PG8_BAR; PG8_WAIT_L(0); PG8_MMA(0, 1, At, B1); PG8_BAR;
            PG8_LDA(At, 1, 1); PG8_STAGE(PG8_SA(1, 0), a3, voffA);
            PG8_BAR; PG8_WAIT_L(0); PG8_MMA(1, 0, At, B0); PG8_BAR; PG8_SCHED;
            PG8_STAGE(PG8_SB(1, 1), b3 + hstep, voffB);
            PG8_WAIT_V(6); PG8_BAR; PG8_MMA(1, 1, At, B1); PG8_BAR;
            }
        }
        if constexpr (ALIGN_EPI) { if (wr == 0) PG8_BAR; }
        if constexpr (!Epi::AFTER_DRAIN) { E(acc, cur, wr, wc, fr, fq); S.done(cur); }
        if (!has_next) break;
#pragma unroll
        for (int a = 0; a < 2; ++a)
#pragma unroll
            for (int b = 0; b < 2; ++b)
#pragma unroll
                for (int m = 0; m < 4; ++m)
#pragma unroll
                    for (int n = 0; n < 2; ++n) acc[a][b][m][n] = (f32x4){0.f, 0.f, 0.f, 0.f};
        cur = nxt; cA = nA; cB = nB; ++ui;
        if constexpr (ALIGN_EPI) { if (wr == 1) PG8_BAR; }
    }
    PG8_WAIT_V(0);
    if constexpr (!ALIGN_EPI) { if (wr == 0) PG8_BAR; }
    PG8_BAR;
#undef PG8_SA
#undef PG8_SB
#undef PG8_STAGE
#undef PG8_LDA
#undef PG8_LDB
#undef PG8_MMA
#undef PG8_WAIT_V
#undef PG8_WAIT_L
#undef PG8_BAR
#undef PG8_SCHED
}
}

constexpr int NWAVES = 8, NTHR = 512;
constexpr int DEPTH = 4, BATCH = 4, SEQ = 4096, DM = 1024, NTOK = BATCH * SEQ;
constexpr int INC = 3592, NPROJ = 3840;
constexpr int C_QA = 0, C_KA = 512, C_VA = 1024, C_QM = 1536, C_KM = 2048, C_VM = 2560, C_OM = 3072, C_IG = 3584, C_FG = 3588;
constexpr int DFF = 2816, DFF2 = 5632;
constexpr int NMEM = 256, NMEMROWS = BATCH * NMEM;
constexpr float EPS = 1e-6f;

constexpr size_t MiB = 1u << 20;
constexpr size_t WS_CTL = 0, CTL_ZERO_BYTES = 64 * 1024;
constexpr size_t WS_SMALL = 256 * 1024;
constexpr size_t WS_WIN = 1 * MiB, WS_WOUT = WS_WIN + (size_t)NPROJ * DM * 2, WS_WQ = WS_WOUT + 2 * MiB, WS_WO = WS_WQ + 2 * MiB,
                 WS_WUP = WS_WO + 2 * MiB, WS_WDN = WS_WUP + (size_t)DFF2 * DM * 2, WS_WEND = WS_WDN + (size_t)DM * DFF * 2;
constexpr size_t WS_KM = 31 * MiB;
constexpr size_t WS_VT = 39 * MiB;
constexpr size_t WS_XN = 47 * MiB;
constexpr size_t WS_GR = 79 * MiB;
constexpr size_t WS_Q = WS_GR, WS_O = WS_GR + 32 * MiB, WS_MIXED = WS_GR + 56 * MiB;
constexpr size_t WS_HM = WS_GR, WS_DC = WS_GR + 16 * MiB, WS_CP = WS_GR + 48 * MiB;
constexpr size_t WS_UR = 167 * MiB;
constexpr size_t WS_PROJ = WS_UR;
constexpr size_t WS_OP = WS_UR + 120 * MiB;
constexpr size_t WS_LSE = WS_UR + 168 * MiB;
constexpr size_t WS_H = WS_UR;
constexpr size_t WS_WKT = WS_UR, WS_WVT = WS_UR + 8 * MiB, WS_MEMB = WS_UR + 16 * MiB;
constexpr size_t WS_END = 343 * MiB;
static_assert(WS_WEND == 31 * MiB, "weight map");
constexpr int SM_DN = 0, SM_NP = 65536, SM_MLOC = 131072, SM_GS = 131072 + 512, SM_MP = 131072 + 1024;

constexpr int CW_BAR = 4096;

constexpr int RING_BYTES = 131072;
constexpr int LDS_MAIN = 143360;
constexpr int MISC_OFF = LDS_MAIN;
constexpr int LDS_BYTES = 147456;

#define GAS __attribute__((address_space(1)))
#define LAS __attribute__((address_space(3)))
typedef unsigned short bf16;
typedef unsigned u32x4 __attribute__((ext_vector_type(4)));
typedef unsigned u32x2 __attribute__((ext_vector_type(2)));
typedef float f32x4 __attribute__((ext_vector_type(4)));
typedef float f32x2 __attribute__((ext_vector_type(2)));
typedef short bf16x8 __attribute__((ext_vector_type(8)));
typedef __bf16 bf16x2_t __attribute__((ext_vector_type(2)));
typedef LAS unsigned char* ldsp;

__device__ __forceinline__ float bf2f(unsigned short h) { return __uint_as_float((unsigned)h << 16); }
__device__ __forceinline__ float bflo(unsigned w) { return __uint_as_float(w << 16); }
__device__ __forceinline__ float bfhi(unsigned w) { return __uint_as_float(w & 0xffff0000u); }
__device__ __forceinline__ unsigned pk2(float lo, float hi) { f32x2 v = {lo, hi}; bf16x2_t b = __builtin_convertvector(v, bf16x2_t); return __builtin_bit_cast(unsigned, b); }
__device__ __forceinline__ void unpack8(const u32x4 w, float* f) { f[0] = bflo(w.x); f[1] = bfhi(w.x); f[2] = bflo(w.y); f[3] = bfhi(w.y); f[4] = bflo(w.z); f[5] = bfhi(w.z); f[6] = bflo(w.w); f[7] = bfhi(w.w); }
__device__ __forceinline__ u32x4 pack8(const float* f) { u32x4 w; w.x = pk2(f[0], f[1]); w.y = pk2(f[2], f[3]); w.z = pk2(f[4], f[5]); w.w = pk2(f[6], f[7]); return w; }
__device__ __forceinline__ float wave_sum(float v) {
#pragma unroll
    for (int o = 1; o < 64; o <<= 1) v += __shfl_xor(v, o);
    return v;
}
#define MFMA16(a, b, c) __builtin_amdgcn_mfma_f32_16x16x32_bf16((a), (b), (c), 0, 0, 0)
#define LDS_WAIT() asm volatile("s_waitcnt lgkmcnt(0)" ::: "memory")

#define XB_TMO      128
#define XB_XCNT(j)  (256  + 64 * (j))
#define XB_XSUB(j)  (1280 + 64 * (j))
#define XB_XGEN(j)  (2304 + 64 * (j))
#define XB_TOP      3328
#define XB_TOPGEN   3392
#define XCD_BAR_WORDS 3456
#define XB_SPIN_CAP (1u << 20)
__device__ __forceinline__ unsigned xb_ld(unsigned* p)              { return __hip_atomic_load(p, __ATOMIC_RELAXED, __HIP_MEMORY_SCOPE_AGENT); }
__device__ __forceinline__ unsigned xb_add(unsigned* p, unsigned v) { return __hip_atomic_fetch_add(p, v, __ATOMIC_RELAXED, __HIP_MEMORY_SCOPE_AGENT); }
__device__ __forceinline__ unsigned xb_xcc_id() { return (unsigned)__builtin_amdgcn_s_getreg((3 << 11) | 20) & 0xFu; }
#define XB_SPIN(cond, bar) do { unsigned _sp = 0; while (cond) { __builtin_amdgcn_s_sleep(1); \
    if ((++_sp & 255u) == 0u) { if (xb_ld(&(bar)[XB_TMO])) break; if (_sp > XB_SPIN_CAP) { atomicAdd(&(bar)[XB_TMO], 1u); break; } } } } while (0)
struct XcdBarrier { unsigned* bar; unsigned x; volatile LAS unsigned* st; };
__device__ __forceinline__ XcdBarrier xcd_barrier_post(unsigned* bar, volatile LAS unsigned* st) {
    XcdBarrier b; b.bar = bar; b.x = xb_xcc_id(); b.st = st;
    if (threadIdx.x == 0) (void)xb_add(&bar[XB_XCNT(b.x)], 1u);
    return b;
}
__device__ __forceinline__ void xcd_barrier_complete(unsigned* bar, unsigned x, unsigned& nloc, unsigned& nx) {
    const unsigned G = gridDim.x * gridDim.y * gridDim.z;
    unsigned sum, cnt, mine, sp = 0u;
    for (;;) {
        sum = 0u; cnt = 0u; mine = 0u;
#pragma unroll
        for (unsigned j = 0; j < 16; ++j) { const unsigned c = xb_ld(&bar[XB_XCNT(j)]); sum += c; cnt += (c > 0u) ? 1u : 0u; mine = (j == x) ? c : mine; }
        if (sum == G) break;
        __builtin_amdgcn_s_sleep(1);
        if ((++sp & 255u) == 0u) { if (xb_ld(&bar[XB_TMO])) break; if (sp > XB_SPIN_CAP) { atomicAdd(&bar[XB_TMO], 1u); break; } }
    }
    nloc = mine > 0u ? mine : 1u; nx = cnt > 0u ? cnt : 1u;
}
__device__ __forceinline__ void xcd_barrier(const XcdBarrier& b) {
    asm volatile("s_waitcnt vmcnt(0)" ::: "memory");
    __syncthreads();
    if (threadIdx.x == 0) {
        unsigned* bar = b.bar;
        __builtin_amdgcn_s_waitcnt(0);
        unsigned nloc = b.st[0], nx = b.st[1];
        if (nloc == 0u) { xcd_barrier_complete(bar, b.x, nloc, nx); b.st[0] = nloc; b.st[1] = nx; }
        const unsigned old = xb_add(&bar[XB_XSUB(b.x)], 1u);
        const unsigned gen = old / nloc;
        if (old + 1u == (gen + 1u) * nloc) {
            __builtin_amdgcn_fence(__ATOMIC_RELEASE, "agent");
            asm volatile("s_waitcnt vmcnt(0)" ::: "memory");
            const unsigned og = xb_add(&bar[XB_TOP], 1u);
            const unsigned tg = og / nx;
            if (og + 1u == (tg + 1u) * nx) xb_add(&bar[XB_TOPGEN], 1u);
            else XB_SPIN(xb_ld(&bar[XB_TOPGEN]) == tg, bar);
            __builtin_amdgcn_fence(__ATOMIC_ACQUIRE, "agent");
            xb_add(&bar[XB_XGEN(b.x)], 1u);
            asm volatile("s_waitcnt vmcnt(0)" ::: "memory");
        } else {
            XB_SPIN(xb_ld(&bar[XB_XGEN(b.x)]) == gen, bar);
            __builtin_amdgcn_fence(__ATOMIC_ACQUIRE, "agent");
            asm volatile("s_waitcnt vmcnt(0)" ::: "memory");
        }
    }
    __syncthreads();
}

struct Args {
    const float* x; const float* mem; const float* rel_bias; const float* pre_mix_g; const float* w_in; const float* mconv_w; const float* mconv_b;
    const float* b_ig; const float* b_fg; const float* attn_out_g; const float* mlstm_out_g; const float* w_out; const float* post_mix_g; const float* pre_mem_g;
    const float* wq; const float* wk; const float* wv; const float* wo; const float* post_mem_g; const float* pre_ffn_g; const float* w_up; const float* fconv_w;
    const float* fconv_b; const float* w_down; const float* post_ffn_g;
    float* out; unsigned char* ws; int ph_lo, ph_hi;
};

__device__ __forceinline__ void transpose_item(const float* W, int K, int N, int Npad, bf16* WT, LAS float* scr, int item, int lane) {
    const int nblk = Npad / 32, kb = item / nblk, nb = item % nblk, k0 = 64 * kb, n0 = 32 * nb;
    const int nn = n0 + (lane & 31); const bool ok = nn < N;
#pragma unroll 8
    for (int i = 0; i < 32; ++i) { const int kk = 2 * i + (lane >> 5); scr[kk * 33 + (lane & 31)] = ok ? W[(size_t)(k0 + kk) * N + nn] : 0.f; }
    LDS_WAIT(); asm volatile("" ::: "memory");
    const int c = lane & 7;
#pragma unroll
    for (int j = 0; j < 4; ++j) { const int n = (lane >> 3) + 8 * j; const LAS float* s = scr + (8 * c) * 33 + n;
        u32x4 o; o.x = pk2(s[0 * 33], s[1 * 33]); o.y = pk2(s[2 * 33], s[3 * 33]); o.z = pk2(s[4 * 33], s[5 * 33]); o.w = pk2(s[6 * 33], s[7 * 33]);
        *(u32x4*)(WT + (size_t)(n0 + n) * K + k0 + 8 * c) = o; }
    LDS_WAIT(); asm volatile("" ::: "memory");
}

__device__ __forceinline__ void convert_layer_weights(const Args& a, int l, ldsp lds, int gw, int NGW, int wave, int lane) {
    LAS float* scr = (LAS float*)(lds + wave * 16384);
    unsigned char* ws = a.ws;
    constexpr int I_IN = (DM / 64) * (NPROJ / 32), I_SQ = (DM / 64) * (DM / 32), I_UP = (DM / 64) * (DFF2 / 32), I_DN = (DFF / 64) * (DM / 32);
    constexpr int NITEMS = I_IN + 3 * I_SQ + I_UP + I_DN;
    for (int it = gw; it < NITEMS; it += NGW) {
        int r = it;
        if (r < I_IN) { transpose_item(a.w_in + (size_t)l * DM * INC, DM, INC, NPROJ, (bf16*)(ws + WS_WIN), scr, r, lane); continue; } r -= I_IN;
        if (r < I_SQ) { transpose_item(a.w_out + (size_t)l * DM * DM, DM, DM, DM, (bf16*)(ws + WS_WOUT), scr, r, lane); continue; } r -= I_SQ;
        if (r < I_SQ) { transpose_item(a.wq + (size_t)l * DM * DM, DM, DM, DM, (bf16*)(ws + WS_WQ), scr, r, lane); continue; } r -= I_SQ;
        if (r < I_SQ) { transpose_item(a.wo + (size_t)l * DM * DM, DM, DM, DM, (bf16*)(ws + WS_WO), scr, r, lane); continue; } r -= I_SQ;
        if (r < I_UP) { transpose_item(a.w_up + (size_t)l * DM * DFF2, DM, DFF2, DFF2, (bf16*)(ws + WS_WUP), scr, r, lane); continue; } r -= I_UP;
        transpose_item(a.w_down + (size_t)l * DFF * DM, DFF, DM, DM, (bf16*)(ws + WS_WDN), scr, r, lane);
    }
}

__device__ __forceinline__ void row_pass(const bf16* H, const float* xin, float* xout, const float* gpost, const float* gpre, bf16* XN, int gw, int NGW, int lane) {
    for (int m = gw; m < NTOK; m += NGW) {
        float xv[2][8];
#pragma unroll
        for (int j = 0; j < 2; ++j) { const float* p = xin + (size_t)m * DM + j * 512 + lane * 8; const f32x4 a0 = *(const f32x4*)p, a1 = *(const f32x4*)(p + 4);
            xv[j][0] = a0[0]; xv[j][1] = a0[1]; xv[j][2] = a0[2]; xv[j][3] = a0[3]; xv[j][4] = a1[0]; xv[j][5] = a1[1]; xv[j][6] = a1[2]; xv[j][7] = a1[3]; }
        if (H) {
            float hv[2][8]; float hs = 0.f;
#pragma unroll
            for (int j = 0; j < 2; ++j) { const u32x4 w = *(const u32x4*)(H + (size_t)m * DM + j * 512 + lane * 8); unpack8(w, hv[j]);
#pragma unroll
                for (int i = 0; i < 8; ++i) hs += hv[j][i] * hv[j][i]; }
            const float rs = rsqrtf(wave_sum(hs) * (1.f / DM) + EPS);
#pragma unroll
            for (int j = 0; j < 2; ++j) { const float* gp = gpost + j * 512 + lane * 8; const f32x4 g0 = *(const f32x4*)gp, g1 = *(const f32x4*)(gp + 4);
#pragma unroll
                for (int i = 0; i < 4; ++i) { xv[j][i] += hv[j][i] * rs * g0[i]; xv[j][4 + i] += hv[j][4 + i] * rs * g1[i]; }
                float* o = xout + (size_t)m * DM + j * 512 + lane * 8;
                *(f32x4*)o = (f32x4){xv[j][0], xv[j][1], xv[j][2], xv[j][3]}; *(f32x4*)(o + 4) = (f32x4){xv[j][4], xv[j][5], xv[j][6], xv[j][7]}; }
        }
        if (XN) {
            float xs = 0.f;
#pragma unroll
            for (int j = 0; j < 2; ++j)
#pragma unroll
                for (int i = 0; i < 8; ++i) xs += xv[j][i] * xv[j][i];
            const float rx = rsqrtf(wave_sum(xs) * (1.f / DM) + EPS);
#pragma unroll
            for (int j = 0; j < 2; ++j) { const float* gp = gpre + j * 512 + lane * 8; const f32x4 g0 = *(const f32x4*)gp, g1 = *(const f32x4*)(gp + 4); float o[8];
#pragma unroll
                for (int i = 0; i < 4; ++i) { o[i] = xv[j][i] * rx * g0[i]; o[4 + i] = xv[j][4 + i] * rx * g1[i]; }
                *(u32x4*)(XN + (size_t)m * DM + j * 512 + lane * 8) = pack8(o); }
        }
    }
}

__device__ __forceinline__ float log_sigmoid(float x) { return fminf(x, 0.f) - log1pf(__expf(-fabsf(x))); }
__device__ __forceinline__ float sigmoidf_(float x) { return 1.f / (1.f + __expf(-x)); }
__device__ __forceinline__ int t5_bucket(int d) {
    if (d < 16) return d;
    int k = 0;
    k += d >= 22; k += d >= 30; k += d >= 40; k += d >= 54; k += d >= 73; k += d >= 99; k += d >= 134; k += d >= 182;
    k += d >= 246; k += d >= 332; k += d >= 450; k += d >= 609; k += d >= 825; k += d >= 1117; k += d >= 1513;
    return 16 + k;
}

constexpr int DA_KP = 144, DA_VP = 528;
constexpr int DA_K = 0, DA_V = 256 * DA_KP, DA_BIAS = DA_V + 64 * DA_VP;
__device__ __forceinline__ void da_unit(const Args& a, ldsp lds, int u) {
    int tid_ = threadIdx.x; asm volatile("" : "+v"(tid_)); const int tid = tid_, lane = tid & 63, wave = __builtin_amdgcn_readfirstlane(tid >> 6), fr = lane & 15, fq = lane >> 4;
    const int bh = u / 96, j = u % 96, b = bh >> 3, h = bh & 7, p = j >> 5, jj = j & 31;
    const int dil = 1 << (2 * p), nbp = 32 >> (2 * p), c = jj / nbp, nb = jj % nbp;
    const bf16* PROJ = (const bf16*)(a.ws + WS_PROJ);
    bf16* OP = (bf16*)(a.ws + WS_OP); float* LSE = (float*)(a.ws + WS_LSE);
    const size_t rowbase = (size_t)b * SEQ;
    LAS float* biasl = (LAS float*)(lds + DA_BIAS);
    if (tid < 129) biasl[tid] = a.rel_bias[t5_bucket(tid * dil) * 8 + h];
    for (int it = tid; it < 2048; it += NTHR) {
        const int kk = it >> 3, ch = it & 7, mk = (nb - 1) * 128 + kk;
        u32x4 kv = {0u, 0u, 0u, 0u}, vv = {0u, 0u, 0u, 0u};
        if (mk >= 0) { const bf16* src = PROJ + (rowbase + (size_t)(mk * dil + c)) * NPROJ + h * 64 + ch * 8; kv = *(const u32x4*)(src + C_KA); vv = *(const u32x4*)(src + C_VA); }
        *(LAS u32x4*)(lds + DA_K + kk * DA_KP + ch * 16) = kv;
        LAS unsigned short* vt = (LAS unsigned short*)(lds + DA_V + (ch * 8) * DA_VP + kk * 2);
        vt[0 * (DA_VP / 2)] = (unsigned short)(vv.x & 0xffffu); vt[1 * (DA_VP / 2)] = (unsigned short)(vv.x >> 16);
        vt[2 * (DA_VP / 2)] = (unsigned short)(vv.y & 0xffffu); vt[3 * (DA_VP / 2)] = (unsigned short)(vv.y >> 16);
        vt[4 * (DA_VP / 2)] = (unsigned short)(vv.z & 0xffffu); vt[5 * (DA_VP / 2)] = (unsigned short)(vv.z >> 16);
        vt[6 * (DA_VP / 2)] = (unsigned short)(vv.w & 0xffffu); vt[7 * (DA_VP / 2)] = (unsigned short)(vv.w >> 16);
    }
    const int qi = wave * 16 + fr, posq = (nb * 128 + qi) * dil + c;
    const size_t qrow = rowbase + posq;
    bf16x8 qf[2];
#pragma unroll
    for (int ks = 0; ks < 2; ++ks) qf[ks] = __builtin_bit_cast(bf16x8, *(const u32x4*)(PROJ + qrow * NPROJ + C_QA + h * 64 + ks * 32 + fq * 8));
    __syncthreads();
    f32x4 s[9]; float mx = -1e30f;
#pragma unroll
    for (int n = 0; n < 9; ++n) {
        f32x4 acc = {0.f, 0.f, 0.f, 0.f}; const int kb = wave + n;
#pragma unroll
        for (int ks = 0; ks < 2; ++ks) { const bf16x8 X = *(const LAS bf16x8*)(lds + DA_K + (kb * 16 + fr) * DA_KP + (ks * 32 + fq * 8) * 2); acc = MFMA16(X, qf[ks], acc); }
#pragma unroll
        for (int r = 0; r < 4; ++r) {
            const int dist = fr + 128 - 16 * n - 4 * fq - r, kk = 16 * kb + 4 * fq + r;
            const bool valid = (dist >= 0) && (dist <= 128) && (nb > 0 || kk >= 128);
            const int dc = dist < 0 ? 0 : (dist > 128 ? 128 : dist);
            const float v = valid ? acc[r] * 0.125f + biasl[dc] : -1e30f;
            acc[r] = v; mx = fmaxf(mx, v);
        }
        s[n] = acc;
    }
    mx = fmaxf(mx, __shfl_xor(mx, 16)); mx = fmaxf(mx, __shfl_xor(mx, 32));
    float l = 0.f;
#pragma unroll
    for (int n = 0; n < 9; ++n)
#pragma unroll
        for (int r = 0; r < 4; ++r) { const float e = __expf(s[n][r] - mx); s[n][r] = e; l += e; }
    l += __shfl_xor(l, 16); l += __shfl_xor(l, 32);
    bf16x8 pf[5];
#pragma unroll
    for (int st = 0; st < 4; ++st) { u32x4 w; w.x = pk2(s[2 * st][0], s[2 * st][1]); w.y = pk2(s[2 * st][2], s[2 * st][3]); w.z = pk2(s[2 * st + 1][0], s[2 * st + 1][1]); w.w = pk2(s[2 * st + 1][2], s[2 * st + 1][3]); pf[st] = __builtin_bit_cast(bf16x8, w); }
    { u32x4 w; w.x = pk2(s[8][0], s[8][1]); w.y = pk2(s[8][2], s[8][3]); w.z = 0u; w.w = 0u; pf[4] = __builtin_bit_cast(bf16x8, w); }
    const float inv = 1.f / l;
#pragma unroll
    for (int nn = 0; nn < 4; ++nn) {
        f32x4 acc = {0.f, 0.f, 0.f, 0.f};
#pragma unroll
        for (int st = 0; st < 5; ++st) {
            const int kb0 = wave + 2 * st, kb1 = st < 4 ? kb0 + 1 : kb0;
            const u32x2 lo = *(const LAS u32x2*)(lds + DA_V + (16 * nn + fr) * DA_VP + (kb0 * 16 + 4 * fq) * 2);
            const u32x2 hi = *(const LAS u32x2*)(lds + DA_V + (16 * nn + fr) * DA_VP + (kb1 * 16 + 4 * fq) * 2);
            const u32x4 xw = {lo.x, lo.y, hi.x, hi.y};
            acc = MFMA16(__builtin_bit_cast(bf16x8, xw), pf[st], acc);
        }
        u32x2 o; o.x = pk2(acc[0] * inv, acc[1] * inv); o.y = pk2(acc[2] * inv, acc[3] * inv);
        *(u32x2*)(OP + ((size_t)p * NTOK + qrow) * 512 + h * 64 + 16 * nn + 4 * fq) = o;
    }
    if (fq == 0) LSE[((size_t)p * NTOK + qrow) * 8 + h] = mx + __logf(l);
    __syncthreads();
}

constexpr int ML_P = 272;
constexpr int ML_T0 = 0, ML_T1 = 128 * ML_P, ML_T2 = 2 * 128 * ML_P, ML_ARR = 3 * 128 * ML_P;
__device__ __forceinline__ void conv4_silu8(const Args& a, int l, const bf16* PROJ, size_t seqrow0, int t, int col0, int chan0, float scale, float* y) {
    const float* cw = a.mconv_w + (size_t)l * 4 * 1024 + chan0; const float* cb = a.mconv_b + (size_t)l * 1024 + chan0;
    { const f32x4 b0 = *(const f32x4*)cb, b1 = *(const f32x4*)(cb + 4); y[0] = b0[0]; y[1] = b0[1]; y[2] = b0[2]; y[3] = b0[3]; y[4] = b1[0]; y[5] = b1[1]; y[6] = b1[2]; y[7] = b1[3]; }
#pragma unroll
    for (int j = 0; j < 4; ++j) { const int tt = t - 3 + j;
        if (tt >= 0) { float xv[8]; unpack8(*(const u32x4*)(PROJ + (seqrow0 + tt) * NPROJ + col0), xv);
            const f32x4 w0 = *(const f32x4*)(cw + j * 1024), w1 = *(const f32x4*)(cw + j * 1024 + 4);
#pragma unroll
            for (int i = 0; i < 4; ++i) { y[i] += w0[i] * xv[i]; y[4 + i] += w1[i] * xv[4 + i]; } } }
#pragma unroll
    for (int i = 0; i < 8; ++i) y[i] = y[i] * sigmoidf_(y[i]) * scale;
}
__device__ __forceinline__ void lds_store_T8(ldsp base, int row0, int col, const float* y) {
#pragma unroll
    for (int i = 0; i < 8; i += 2) { const unsigned w = pk2(y[i], y[i + 1]);
        *(LAS unsigned short*)(base + (row0 + i) * ML_P + col * 2) = (unsigned short)(w & 0xffffu); *(LAS unsigned short*)(base + (row0 + i + 1) * ML_P + col * 2) = (unsigned short)(w >> 16); }
}

__device__ __forceinline__ void m1_unit(const Args& a, int l, ldsp lds, int u) {
    int tid_ = threadIdx.x; asm volatile("" : "+v"(tid_)); const int tid = tid_, lane = tid & 63, wave = __builtin_amdgcn_readfirstlane(tid >> 6), fr = lane & 15, fq = lane >> 4;
    const int bh = u >> 5, c = u & 31, b = bh >> 2, h = bh & 3;
    const bf16* PROJ = (const bf16*)(a.ws + WS_PROJ);
    const size_t seqrow0 = (size_t)b * SEQ; const int t0 = c * 128;
    LAS float* lf = (LAS float*)(lds + ML_ARR); LAS float* igs = lf + 128; LAS float* bc = lf + 256; LAS float* wl = lf + 384; LAS float* wt = lf + 512;
    if (tid < 128) { const size_t row = seqrow0 + t0 + tid;
        igs[tid] = bf2f(PROJ[row * NPROJ + C_IG + h]) + a.b_ig[l * 4 + h]; lf[tid] = log_sigmoid(bf2f(PROJ[row * NPROJ + C_FG + h]) + a.b_fg[l * 4 + h]); }
    __syncthreads();
    if (tid < 128) { float s = 0.f; for (int i = 0; i <= tid; ++i) s += lf[i]; bc[tid] = s; }
    __syncthreads();
    const float g = bc[127];
    if (tid < 128) wl[tid] = g - bc[tid] + igs[tid];
    __syncthreads();
    float mloc = -1e30f; for (int i = 0; i < 128; ++i) mloc = fmaxf(mloc, wl[i]);
    if (tid < 128) wt[tid] = __expf(wl[tid] - mloc);
    __syncthreads();
    for (int it = tid; it < 2048; it += NTHR) {
        const int s = it >> 4, ch = it & 15; float y[8];
        conv4_silu8(a, l, PROJ, seqrow0, t0 + s, C_KM + h * 128 + ch * 8, 512 + h * 128 + ch * 8, 0.08838834764831845f, y);
        lds_store_T8(lds + ML_T0, ch * 8, s, y);
        unpack8(*(const u32x4*)(PROJ + (seqrow0 + t0 + s) * NPROJ + C_VM + h * 128 + ch * 8), y);
        const float w = wt[s];
#pragma unroll
        for (int i = 0; i < 8; ++i) y[i] *= w;
        lds_store_T8(lds + ML_T1, ch * 8, s, y);
    }
    __syncthreads();
    float* dC = (float*)(a.ws + WS_DC) + (size_t)u * 16384;
    bf16x8 xv[4];
#pragma unroll
    for (int ks = 0; ks < 4; ++ks) xv[ks] = *(const LAS bf16x8*)(lds + ML_T1 + (16 * wave + fr) * ML_P + (32 * ks + 8 * fq) * 2);
#pragma unroll
    for (int n = 0; n < 8; ++n) {
        f32x4 acc = {0.f, 0.f, 0.f, 0.f};
#pragma unroll
        for (int ks = 0; ks < 4; ++ks) { const bf16x8 Y = *(const LAS bf16x8*)(lds + ML_T0 + (16 * n + fr) * ML_P + (32 * ks + 8 * fq) * 2); acc = MFMA16(xv[ks], Y, acc); }
#pragma unroll
        for (int r = 0; r < 4; ++r) dC[(16 * wave + 4 * fq + r) * 128 + 16 * n + fr] = acc[r];
    }
    float* sm = (float*)(a.ws + WS_SMALL);
    if (tid < 128) { float s = 0.f; for (int i = 0; i < 128; ++i) s += wt[i] * bf2f(*(const LAS unsigned short*)(lds + ML_T0 + tid * ML_P + i * 2)); sm[SM_DN + u * 128 + tid] = s; }
    if (tid == 0) { sm[SM_MLOC + u] = mloc; sm[SM_GS + u] = g; }
    __syncthreads();
}

__device__ __forceinline__ void m2_scan(const Args& a, int gtid, int nthreads) {
    float* sm = (float*)(a.ws + WS_SMALL);
    const float* dC = (const float*)(a.ws + WS_DC); bf16* CP = (bf16*)(a.ws + WS_CP);
    for (int idx = gtid; idx < 16 * 16384 + 16 * 128; idx += nthreads) {
        const bool isn = idx >= 16 * 16384; const int id2 = isn ? idx - 16 * 16384 : idx;
        const int bh = isn ? (id2 >> 7) : (id2 >> 14), e = isn ? (id2 & 127) : (id2 & 16383);
        float m = 0.f, v = 0.f;
        for (int c = 0; c < 32; ++c) {
            const int u = bh * 32 + c;
            const float g = sm[SM_GS + u], ml = sm[SM_MLOC + u];
            float d;
            if (isn) { sm[SM_NP + u * 128 + e] = v; if (e == 0) sm[SM_MP + u] = m; d = sm[SM_DN + u * 128 + e]; }
            else { CP[(size_t)u * 16384 + e] = (bf16)(pk2(v, 0.f) & 0xffffu); d = dC[(size_t)u * 16384 + e]; }
            const float mn = fmaxf(g + m, ml);
            v = __expf(g + m - mn) * v + __expf(ml - mn) * d; m = mn;
        }
    }
}

__device__ __forceinline__ void m3_unit(const Args& a, int l, ldsp lds, int u) {
    int tid_ = threadIdx.x; asm volatile("" : "+v"(tid_)); const int tid = tid_, lane = tid & 63, wave = __builtin_amdgcn_readfirstlane(tid >> 6), fr = lane & 15, fq = lane >> 4;
    const int bh = u >> 5, c = u & 31, b = bh >> 2, h = bh & 3;
    const bf16* PROJ = (const bf16*)(a.ws + WS_PROJ);
    const size_t seqrow0 = (size_t)b * SEQ; const int t0 = c * 128;
    const float* sm = (const float*)(a.ws + WS_SMALL);
    LAS float* lf = (LAS float*)(lds + ML_ARR); LAS float* igs = lf + 128; LAS float* bc = lf + 256; LAS float* ev = lf + 384; LAS float* mxv = lf + 512; LAS float* npl = lf + 640;
    const float mP = sm[SM_MP + u];
    if (tid < 128) { const size_t row = seqrow0 + t0 + tid;
        igs[tid] = bf2f(PROJ[row * NPROJ + C_IG + h]) + a.b_ig[l * 4 + h]; lf[tid] = log_sigmoid(bf2f(PROJ[row * NPROJ + C_FG + h]) + a.b_fg[l * 4 + h]);
        npl[tid] = sm[SM_NP + u * 128 + tid]; }
    __syncthreads();
    if (tid < 128) { float s = 0.f; for (int i = 0; i <= tid; ++i) s += lf[i]; bc[tid] = s; ev[tid] = igs[tid] - s; }
    __syncthreads();
    if (tid < 128) { float m = mP; for (int i = 0; i <= tid; ++i) m = fmaxf(m, ev[i]); mxv[tid] = m; }
    for (int it = tid; it < 2048; it += NTHR) {
        const int s = it >> 4, ch = it & 15; float y[8];
        conv4_silu8(a, l, PROJ, seqrow0, t0 + s, C_QM + h * 128 + ch * 8, h * 128 + ch * 8, 1.f, y);
        *(LAS u32x4*)(lds + ML_T0 + s * ML_P + ch * 16) = pack8(y);
        conv4_silu8(a, l, PROJ, seqrow0, t0 + s, C_KM + h * 128 + ch * 8, 512 + h * 128 + ch * 8, 0.08838834764831845f, y);
        *(LAS u32x4*)(lds + ML_T1 + s * ML_P + ch * 16) = pack8(y);
        unpack8(*(const u32x4*)(PROJ + (seqrow0 + t0 + s) * NPROJ + C_VM + h * 128 + ch * 8), y);
        lds_store_T8(lds + ML_T2, ch * 8, s, y);
    }
    __syncthreads();
    const int t = 16 * wave + fr;
    bf16x8 qf[4];
#pragma unroll
    for (int ks = 0; ks < 4; ++ks) qf[ks] = *(const LAS bf16x8*)(lds + ML_T0 + t * ML_P + (32 * ks + 8 * fq) * 2);
    const float mx_t = mxv[t];
    f32x4 s[8]; float rs = 0.f;
#pragma unroll
    for (int n = 0; n < 8; ++n) {
        f32x4 acc = {0.f, 0.f, 0.f, 0.f};
        if (n <= wave) {
#pragma unroll
            for (int ks = 0; ks < 4; ++ks) { const bf16x8 X = *(const LAS bf16x8*)(lds + ML_T1 + (16 * n + fr) * ML_P + (32 * ks + 8 * fq) * 2); acc = MFMA16(X, qf[ks], acc); }
#pragma unroll
            for (int r = 0; r < 4; ++r) { const int si = 16 * n + 4 * fq + r; const float pv = (si <= t) ? __expf(ev[si] - mx_t) * acc[r] : 0.f; acc[r] = pv; rs += pv; }
        }
        s[n] = acc;
    }
    rs += __shfl_xor(rs, 16); rs += __shfl_xor(rs, 32);
    float nq = 0.f;
#pragma unroll
    for (int ks = 0; ks < 4; ++ks) { float qv[8]; unpack8(__builtin_bit_cast(u32x4, qf[ks]), qv);
#pragma unroll
        for (int i = 0; i < 8; ++i) nq += qv[i] * npl[32 * ks + 8 * fq + i]; }
    nq += __shfl_xor(nq, 16); nq += __shfl_xor(nq, 32);
    const float inter = __expf(mP - mx_t);
    const float den = inter * nq + rs, m_t = bc[t] + mx_t;
    const float inv = 1.f / fmaxf(fabsf(den), __expf(-m_t));
    bf16x8 pf[4];
#pragma unroll
    for (int st = 0; st < 4; ++st) { u32x4 w; w.x = pk2(s[2 * st][0], s[2 * st][1]); w.y = pk2(s[2 * st][2], s[2 * st][3]); w.z = pk2(s[2 * st + 1][0], s[2 * st + 1][1]); w.w = pk2(s[2 * st + 1][2], s[2 * st + 1][3]); pf[st] = __builtin_bit_cast(bf16x8, w); }
    const bf16* CPu = (const bf16*)(a.ws + WS_CP) + (size_t)u * 16384;
    bf16* HM = (bf16*)(a.ws + WS_HM);
    const size_t row = seqrow0 + t0 + t;
#pragma unroll
    for (int nn = 0; nn < 8; ++nn) {
        f32x4 acc = {0.f, 0.f, 0.f, 0.f};
#pragma unroll
        for (int ks = 0; ks < 4; ++ks) { const bf16x8 X = __builtin_bit_cast(bf16x8, *(const u32x4*)(CPu + (16 * nn + fr) * 128 + 32 * ks + 8 * fq)); acc = MFMA16(X, qf[ks], acc); }
#pragma unroll
        for (int r = 0; r < 4; ++r) acc[r] *= inter;
#pragma unroll
        for (int st = 0; st < 4; ++st) if (2 * st <= wave) {
            const u32x2 lo = *(const LAS u32x2*)(lds + ML_T2 + (16 * nn + fr) * ML_P + (32 * st + 4 * fq) * 2);
            const u32x2 hi = *(const LAS u32x2*)(lds + ML_T2 + (16 * nn + fr) * ML_P + (32 * st + 16 + 4 * fq) * 2);
            const u32x4 xw = {lo.x, lo.y, hi.x, hi.y};
            acc = MFMA16(__builtin_bit_cast(bf16x8, xw), pf[st], acc);
        }
        const u32x2 omw = *(const u32x2*)(PROJ + row * NPROJ + C_OM + h * 128 + 16 * nn + 4 * fq);
        const float o0 = acc[0] * inv * sigmoidf_(bflo(omw.x)), o1 = acc[1] * inv * sigmoidf_(bfhi(omw.x)), o2 = acc[2] * inv * sigmoidf_(bflo(omw.y)), o3 = acc[3] * inv * sigmoidf_(bfhi(omw.y));
        u32x2 o; o.x = pk2(o0, o1); o.y = pk2(o2, o3);
        *(u32x2*)(HM + row * 512 + h * 128 + 16 * nn + 4 * fq) = o;
    }
    __syncthreads();
}

__device__ __forceinline__ void mix_pass(const Args& a, int l, int gw, int NGW, int lane) {
    const bf16* OP = (const bf16*)(a.ws + WS_OP); const float* LSE = (const float*)(a.ws + WS_LSE); const bf16* HM = (const bf16*)(a.ws + WS_HM);
    bf16* MIXED = (bf16*)(a.ws + WS_MIXED);
    const float* ga = a.attn_out_g + (size_t)l * 512 + lane * 8; const float* gm = a.mlstm_out_g + (size_t)l * 512 + lane * 8;
    const int hd = lane >> 3;
    for (int m = gw; m < NTOK; m += NGW) {
        const float l0 = LSE[((size_t)0 * NTOK + m) * 8 + hd], l1 = LSE[((size_t)1 * NTOK + m) * 8 + hd], l2 = LSE[((size_t)2 * NTOK + m) * 8 + hd];
        const float lm = fmaxf(l0, fmaxf(l1, l2)); float w0 = __expf(l0 - lm), w1 = __expf(l1 - lm), w2 = __expf(l2 - lm); const float wi = 1.f / (w0 + w1 + w2); w0 *= wi; w1 *= wi; w2 *= wi;
        float o0[8], o1[8], o2[8], at[8];
        unpack8(*(const u32x4*)(OP + ((size_t)0 * NTOK + m) * 512 + lane * 8), o0); unpack8(*(const u32x4*)(OP + ((size_t)1 * NTOK + m) * 512 + lane * 8), o1); unpack8(*(const u32x4*)(OP + ((size_t)2 * NTOK + m) * 512 + lane * 8), o2);
        float ss = 0.f;
#pragma unroll
        for (int i = 0; i < 8; ++i) { at[i] = w0 * o0[i] + w1 * o1[i] + w2 * o2[i]; ss += at[i] * at[i]; }
        const float ra = rsqrtf(wave_sum(ss) * (1.f / 512.f) + EPS);
        { const f32x4 g0 = *(const f32x4*)ga, g1 = *(const f32x4*)(ga + 4);
#pragma unroll
          for (int i = 0; i < 4; ++i) { at[i] *= ra * g0[i]; at[4 + i] *= ra * g1[i]; } }
        *(u32x4*)(MIXED + (size_t)m * DM + lane * 8) = pack8(at);
        float hv[8]; unpack8(*(const u32x4*)(HM + (size_t)m * 512 + lane * 8), hv);
        float hs = 0.f;
#pragma unroll
        for (int i = 0; i < 8; ++i) hs += hv[i] * hv[i];
        const float rh = rsqrtf(wave_sum(hs) * (1.f / 512.f) + EPS);
        { const f32x4 g0 = *(const f32x4*)gm, g1 = *(const f32x4*)(gm + 4);
#pragma unroll
          for (int i = 0; i < 4; ++i) { hv[i] *= rh * g0[i]; hv[4 + i] *= rh * g1[i]; } }
        *(u32x4*)(MIXED + (size_t)m * DM + 512 + lane * 8) = pack8(hv);
    }
}

constexpr int XA_P = 528;
__device__ __forceinline__ void xa_unit(const Args& a, int l, ldsp lds, int u) {
    int tid_ = threadIdx.x; asm volatile("" : "+v"(tid_)); const int tid = tid_, lane = tid & 63, wave = __builtin_amdgcn_readfirstlane(tid >> 6), fr = lane & 15, fq = lane >> 4;
    const int bh = u >> 5, qb = u & 31, b = bh >> 2, h = bh & 3;
    const bf16* Q = (const bf16*)(a.ws + WS_Q); bf16* O = (bf16*)(a.ws + WS_O);
    const bf16* KM = (const bf16*)(a.ws + WS_KM); const bf16* VT = (const bf16*)(a.ws + WS_VT);
    const size_t row = (size_t)b * SEQ + qb * 128 + wave * 16 + fr;
    for (int it = tid; it < 8192; it += NTHR) { const int key = it >> 5, ch = it & 31;
        *(LAS u32x4*)(lds + key * XA_P + ch * 16) = *(const u32x4*)(KM + (size_t)(b * NMEM + key) * 4096 + l * 1024 + h * 256 + ch * 8); }
    bf16x8 qf[8];
#pragma unroll
    for (int ks = 0; ks < 8; ++ks) qf[ks] = __builtin_bit_cast(bf16x8, *(const u32x4*)(Q + row * DM + h * 256 + ks * 32 + fq * 8));
    __syncthreads();
    f32x4 s[16]; float mx = -1e30f;
#pragma unroll
    for (int n = 0; n < 16; ++n) {
        f32x4 acc = {0.f, 0.f, 0.f, 0.f};
#pragma unroll
        for (int ks = 0; ks < 8; ++ks) { const bf16x8 X = *(const LAS bf16x8*)(lds + (16 * n + fr) * XA_P + (32 * ks + 8 * fq) * 2); acc = MFMA16(X, qf[ks], acc); }
#pragma unroll
        for (int r = 0; r < 4; ++r) { acc[r] *= 0.0625f; mx = fmaxf(mx, acc[r]); }
        s[n] = acc;
    }
    mx = fmaxf(mx, __shfl_xor(mx, 16)); mx = fmaxf(mx, __shfl_xor(mx, 32));
    float lsum = 0.f;
#pragma unroll
    for (int n = 0; n < 16; ++n)
#pragma unroll
        for (int r = 0; r < 4; ++r) { const float e = __expf(s[n][r] - mx); s[n][r] = e; lsum += e; }
    lsum += __shfl_xor(lsum, 16); lsum += __shfl_xor(lsum, 32);
    const float inv = 1.f / lsum;
    bf16x8 pf[8];
#pragma unroll
    for (int st = 0; st < 8; ++st) { u32x4 w; w.x = pk2(s[2 * st][0], s[2 * st][1]); w.y = pk2(s[2 * st][2], s[2 * st][3]); w.z = pk2(s[2 * st + 1][0], s[2 * st + 1][1]); w.w = pk2(s[2 * st + 1][2], s[2 * st + 1][3]); pf[st] = __builtin_bit_cast(bf16x8, w); }
    __syncthreads();
    for (int it = tid; it < 8192; it += NTHR) { const int d = it >> 5, ch = it & 31;
        *(LAS u32x4*)(lds + d * XA_P + ch * 16) = *(const u32x4*)(VT + (size_t)(l * 1024 + h * 256 + d) * NMEMROWS + b * NMEM + ch * 8); }
    __syncthreads();
#pragma unroll
    for (int nn = 0; nn < 16; ++nn) {
        f32x4 acc = {0.f, 0.f, 0.f, 0.f};
#pragma unroll
        for (int st = 0; st < 8; ++st) {
            const u32x2 lo = *(const LAS u32x2*)(lds + (16 * nn + fr) * XA_P + (32 * st + 4 * fq) * 2);
            const u32x2 hi = *(const LAS u32x2*)(lds + (16 * nn + fr) * XA_P + (32 * st + 16 + 4 * fq) * 2);
            const u32x4 xw = {lo.x, lo.y, hi.x, hi.y};
            acc = MFMA16(__builtin_bit_cast(bf16x8, xw), pf[st], acc);
        }
        u32x2 o; o.x = pk2(acc[0] * inv, acc[1] * inv); o.y = pk2(acc[2] * inv, acc[3] * inv);
        *(u32x2*)(O + row * DM + h * 256 + 16 * nn + 4 * fq) = o;
    }
    __syncthreads();
}

__device__ __forceinline__ float gelu_tanh(float x) { const float z = 0.7978845608028654f * (x + 0.044715f * x * x * x); const float t = 1.f - 2.f / (__expf(2.f * z) + 1.f); return 0.5f * x * (1.f + t); }
__device__ __forceinline__ void cg_item(const Args& a, int l, int item) {
    int tid_ = threadIdx.x; asm volatile("" : "+v"(tid_)); const int tid = tid_; if (tid >= 352) return;
    const bf16* U = (const bf16*)(a.ws + WS_UR); bf16* G = (bf16*)(a.ws + WS_GR);
    const int r0 = item * 32, t0 = r0 & (SEQ - 1), c0 = tid * 8;
    const float* fw = a.fconv_w + (size_t)l * 3 * DFF2; const float* fb = a.fconv_b + (size_t)l * DFF2;
    float wa[3][8], wg[3][8], ba[8], bg[8];
#pragma unroll
    for (int j = 0; j < 3; ++j) { const f32x4 p0 = *(const f32x4*)(fw + j * DFF2 + c0), p1 = *(const f32x4*)(fw + j * DFF2 + c0 + 4), q0 = *(const f32x4*)(fw + j * DFF2 + DFF + c0), q1 = *(const f32x4*)(fw + j * DFF2 + DFF + c0 + 4);
#pragma unroll
        for (int i = 0; i < 4; ++i) { wa[j][i] = p0[i]; wa[j][4 + i] = p1[i]; wg[j][i] = q0[i]; wg[j][4 + i] = q1[i]; } }
    { const f32x4 p0 = *(const f32x4*)(fb + c0), p1 = *(const f32x4*)(fb + c0 + 4), q0 = *(const f32x4*)(fb + DFF + c0), q1 = *(const f32x4*)(fb + DFF + c0 + 4);
#pragma unroll
      for (int i = 0; i < 4; ++i) { ba[i] = p0[i]; ba[4 + i] = p1[i]; bg[i] = q0[i]; bg[4 + i] = q1[i]; } }
    float a1[8], a2[8], g1[8], g2[8];
#pragma unroll
    for (int i = 0; i < 8; ++i) { a1[i] = 0.f; a2[i] = 0.f; g1[i] = 0.f; g2[i] = 0.f; }
    if (t0 > 0) { unpack8(*(const u32x4*)(U + (size_t)(r0 - 1) * DFF2 + c0), a1); unpack8(*(const u32x4*)(U + (size_t)(r0 - 1) * DFF2 + DFF + c0), g1);
                  unpack8(*(const u32x4*)(U + (size_t)(r0 - 2) * DFF2 + c0), a2); unpack8(*(const u32x4*)(U + (size_t)(r0 - 2) * DFF2 + DFF + c0), g2); }
    for (int rr = 0; rr < 32; rr += 4) {
        u32x4 ua[4], ug[4];
#pragma unroll
        for (int k = 0; k < 4; ++k) { ua[k] = *(const u32x4*)(U + (size_t)(r0 + rr + k) * DFF2 + c0); ug[k] = *(const u32x4*)(U + (size_t)(r0 + rr + k) * DFF2 + DFF + c0); }
#pragma unroll
        for (int k = 0; k < 4; ++k) {
            float a0[8], g0[8], o[8]; unpack8(ua[k], a0); unpack8(ug[k], g0);
#pragma unroll
            for (int i = 0; i < 8; ++i) { const float av = ba[i] + wa[0][i] * a2[i] + wa[1][i] * a1[i] + wa[2][i] * a0[i]; const float gv = bg[i] + wg[0][i] * g2[i] + wg[1][i] * g1[i] + wg[2][i] * g0[i];
                o[i] = gelu_tanh(gv) * av; a2[i] = a1[i]; a1[i] = a0[i]; g2[i] = g1[i]; g1[i] = g0[i]; }
            *(u32x4*)(G + (size_t)(r0 + rr + k) * DFF + c0) = pack8(o);
        }
    }
}


#ifdef SKIP_M1
#define SK_M1(x)
#else
#define SK_M1(x) x
#endif
#ifdef SKIP_DA
#define SK_DA(x)
#else
#define SK_DA(x) x
#endif
#ifdef SKIP_M2
#define SK_M2(x)
#else
#define SK_M2(x) x
#endif
#ifdef SKIP_M3
#define SK_M3(x)
#else
#define SK_M3(x) x
#endif
#ifdef SKIP_MIX
#define SK_MIX(x)
#else
#define SK_MIX(x) x
#endif
#ifdef SKIP_XA
#define SK_XA(x)
#else
#define SK_XA(x) x
#endif
#ifdef SKIP_CG
#define SK_CG(x)
#else
#define SK_CG(x) x
#endif
constexpr int N_PHASES = 2 + 15 * DEPTH;
__global__ void __launch_bounds__(NTHR, 2) mk_fwd(Args a) {
    extern __shared__ __attribute__((aligned(16))) unsigned char lds_raw[];
    const ldsp lds = (ldsp)lds_raw;
    volatile LAS unsigned* MISC = (volatile LAS unsigned*)(lds + MISC_OFF);
    const int G = gridDim.x, bid = blockIdx.x;
    unsigned char* ws = a.ws;
    if (threadIdx.x < 64) MISC[threadIdx.x] = 0u;
    __syncthreads();
    XcdBarrier bar; bar.bar = (unsigned*)(ws + WS_CTL) + CW_BAR; bar.x = 0; bar.st = nullptr;
    const bool multi = (a.ph_hi - a.ph_lo) > 1;
    if (multi) bar = xcd_barrier_post((unsigned*)(ws + WS_CTL) + CW_BAR, MISC + 8);
    cg::grid_group grid = cg::this_grid();

#ifdef SINGLE_PH
    { const int ph = a.ph_lo;
#else
    for (int ph = a.ph_lo; ph < a.ph_hi; ++ph) {
#endif
        int tidl = threadIdx.x; asm volatile("" : "+v"(tidl));
        const int tid = tidl, lane = tid & 63, wave = __builtin_amdgcn_readfirstlane(tid >> 6);
        const int gw = bid * NWAVES + wave, NGW = G * NWAVES;
        if (ph == 0) {
            convert_layer_weights(a, 0, lds, gw, NGW, wave, lane);
            LAS float* scr = (LAS float*)(lds + wave * 16384);
            constexpr int I_SQ = (DM / 64) * (DM / 32);
            for (int it = gw; it < 8 * I_SQ; it += NGW) { const int mtx = it / I_SQ, r = it % I_SQ, l = mtx >> 1;
                if ((mtx & 1) == 0) transpose_item(a.wk + (size_t)l * DM * DM, DM, DM, DM, (bf16*)(ws + WS_WKT) + (size_t)l * DM * DM, scr, r, lane);
                else transpose_item(a.wv + (size_t)l * DM * DM, DM, DM, DM, (bf16*)(ws + WS_WVT) + (size_t)l * DM * DM, scr, r, lane); }
            for (int i = bid * NTHR + tid; i < NMEMROWS * DM / 8; i += G * NTHR) { const f32x4 v0 = *(const f32x4*)(a.mem + (size_t)i * 8), v1 = *(const f32x4*)(a.mem + (size_t)i * 8 + 4);
                u32x4 w; w.x = pk2(v0[0], v0[1]); w.y = pk2(v0[2], v0[3]); w.z = pk2(v1[0], v1[1]); w.w = pk2(v1[2], v1[3]); *(u32x4*)((bf16*)(ws + WS_MEMB) + (size_t)i * 8) = w; }
            row_pass(nullptr, a.x, nullptr, nullptr, a.pre_mix_g, (bf16*)(ws + WS_XN), gw, NGW, lane);
        }
#ifndef SKIP_KV
        else if (ph == 1) {
            { pg8::Gemm g{(const bf16*)(ws + WS_MEMB), (const bf16*)(ws + WS_WKT), NMEMROWS, 4096, DM}; pg8::StaticOrder S; S.init(NMEMROWS, 4096, G, bid);
              pg8::EpiBf16 E{(bf16*)(ws + WS_KM), 4096}; pg8::gemm_phase<pg8::EpiBf16, pg8::StaticOrder, true, true>(lds, g, S, E); }
            { pg8::Gemm g{(const bf16*)(ws + WS_WVT), (const bf16*)(ws + WS_MEMB), 4096, NMEMROWS, DM}; pg8::StaticOrder S; S.init(4096, NMEMROWS, G, (bid + G / 2) % G);
              pg8::EpiBf16 E{(bf16*)(ws + WS_VT), NMEMROWS}; pg8::gemm_phase<pg8::EpiBf16, pg8::StaticOrder, true, true>(lds, g, S, E); }
        }
#endif
        else {
            const int l = (ph - 2) / 15, st = (ph - 2) % 15;
            const bf16* gA = nullptr; const bf16* gB = nullptr; bf16* gO = nullptr; int gN = 0, gK = 0;
            switch (st) {
                case 0:  gA = (const bf16*)(ws + WS_XN);    gB = (const bf16*)(ws + WS_WIN);  gO = (bf16*)(ws + WS_PROJ); gN = NPROJ; gK = DM; break;
                case 5:  gA = (const bf16*)(ws + WS_MIXED); gB = (const bf16*)(ws + WS_WOUT); gO = (bf16*)(ws + WS_H);    gN = DM;    gK = DM; break;
                case 7:  gA = (const bf16*)(ws + WS_XN);    gB = (const bf16*)(ws + WS_WQ);   gO = (bf16*)(ws + WS_Q);    gN = DM;    gK = DM; break;
                case 9:  gA = (const bf16*)(ws + WS_O);     gB = (const bf16*)(ws + WS_WO);   gO = (bf16*)(ws + WS_H);    gN = DM;    gK = DM; break;
                case 11: gA = (const bf16*)(ws + WS_XN);    gB = (const bf16*)(ws + WS_WUP);  gO = (bf16*)(ws + WS_UR);   gN = DFF2;  gK = DM; break;
                case 13: gA = (const bf16*)(ws + WS_GR);    gB = (const bf16*)(ws + WS_WDN);  gO = (bf16*)(ws + WS_H);    gN = DM;    gK = DFF; break;
                default: break;
            }
            if (gA) {
                pg8::Gemm g{gA, gB, NTOK, gN, gK}; pg8::StaticOrder S; S.init(NTOK, gN, G, bid);
                pg8::EpiBf16 E{gO, gN}; pg8::gemm_phase<pg8::EpiBf16, pg8::StaticOrder, true, true>(lds, g, S, E);
            } else if (st == 1) {
                for (int u = bid; u < 512 + 3072; u += G) { if (u < 512) { SK_M1(m1_unit(a, l, lds, u)); } else { SK_DA(da_unit(a, lds, u - 512)); } }
            } else if (st == 2) {
                SK_M2(m2_scan(a, bid * NTHR + tid, G * NTHR));
            } else if (st == 3) {
                for (int u = bid; u < 512; u += G) { SK_M3(m3_unit(a, l, lds, u)); }
            } else if (st == 4) {
                SK_MIX(mix_pass(a, l, gw, NGW, lane));
            } else if (st == 6) {
                row_pass((const bf16*)(ws + WS_H), l == 0 ? a.x : a.out, a.out, a.post_mix_g + (size_t)l * DM, a.pre_mem_g + (size_t)l * DM, (bf16*)(ws + WS_XN), gw, NGW, lane);
            } else if (st == 8) {
                for (int u = bid; u < 512; u += G) { SK_XA(xa_unit(a, l, lds, u)); }
            } else if (st == 10) {
                row_pass((const bf16*)(ws + WS_H), a.out, a.out, a.post_mem_g + (size_t)l * DM, a.pre_ffn_g + (size_t)l * DM, (bf16*)(ws + WS_XN), gw, NGW, lane);
            } else if (st == 12) {
                for (int it = bid; it < NTOK / 32; it += G) { SK_CG(cg_item(a, l, it)); }
            } else if (st == 14) {
                const bool lastl = (l == DEPTH - 1);
                row_pass((const bf16*)(ws + WS_H), a.out, a.out, a.post_ffn_g + (size_t)l * DM, lastl ? nullptr : a.pre_mix_g + (size_t)(l + 1) * DM, lastl ? nullptr : (bf16*)(ws + WS_XN), gw, NGW, lane);
                if (!lastl) convert_layer_weights(a, l + 1, lds, gw, NGW, wave, lane);
            }
        }
        if (ph + 1 < a.ph_hi) { if (ph == a.ph_lo) grid.sync(); else xcd_barrier(bar); }
    }
}

extern "C" void kernel_launch(void* const* d_in, const int* in_sizes, int n_in, void* d_out, int out_size, void* d_ws, size_t ws_size, hipStream_t stream) {
    static int grid = 0;
    if (grid == 0) {
        if (n_in != 25 || out_size != NTOK * DM || ws_size < WS_END) { fprintf(stderr, "kernel_launch: unexpected shapes (n_in %d out %d ws %zu need %zu)\n", n_in, out_size, ws_size, (size_t)WS_END); grid = -1; return; }
        int dev = 0, cus = 0, per_cu = 0;
        hipGetDevice(&dev); hipDeviceGetAttribute(&cus, hipDeviceAttributeMultiprocessorCount, dev);
        hipFuncSetAttribute((const void*)mk_fwd, hipFuncAttributeMaxDynamicSharedMemorySize, LDS_BYTES);
        hipOccupancyMaxActiveBlocksPerMultiprocessor(&per_cu, (const void*)mk_fwd, NTHR, LDS_BYTES);
        (void)hipGetLastError();
        if (per_cu < 1) per_cu = 1;
        grid = cus * 1;
        if (grid <= 0) grid = 256;
    }
    if (grid < 0) return;
    hipMemsetAsync((char*)d_ws + WS_CTL, 0, CTL_ZERO_BYTES, stream);
    Args a{};
    const float** ap = (const float**)&a;
    for (int i = 0; i < 25; ++i) ap[i] = (const float*)d_in[i];
    a.out = (float*)d_out; a.ws = (unsigned char*)d_ws;
#if MK_PER_PHASE_LAUNCH
    for (int ph = 0; ph < N_PHASES; ++ph) { a.ph_lo = ph; a.ph_hi = ph + 1; hipLaunchKernelGGL(mk_fwd, dim3(grid), dim3(NTHR), LDS_BYTES, stream, a); }
#else
    a.ph_lo = 0; a.ph_hi = N_PHASES;
    void* args[] = {&a};
    hipError_t e = hipLaunchCooperativeKernel((const void*)mk_fwd, dim3(grid), dim3(NTHR), args, LDS_BYTES, stream);
    if (e != hipSuccess) fprintf(stderr, "cooperative launch failed: %s (grid %d)\n", hipGetErrorString(e), grid);
#endif
}
```
